# Optimizing an MI355X kernel written in HIP

```python
import jax, jax.numpy as jnp
from jax import lax
import numpy as np

D_MODEL = 1024
BATCH = 1
SEQ = 16384
DEPTH = 2
DEC_BATCH = 8
DEC_SEQ = 64
PAST_LEN = 1024

CHUNK = 64
HEAD_DIM = 64
A_Q_HEADS = 8
A_KV_HEADS = 2
A_GROUP = A_Q_HEADS // A_KV_HEADS
A_WINDOW = 128
A_PREV_CHUNKS = A_WINDOW // CHUNK
ROPE_THETA = 500000.0
ROPE_DIM = HEAD_DIM // 4
B_HEADS = 8
B_PREV_CHUNKS = 8
B_REACH = B_PREV_CHUNKS * CHUNK
REL_CLIP = 128
C_HEADS = 4
C_KEY_DIM = 128
C_VAL_DIM = 128
REC_BLOCK = 16
D_FF = 2816
CONV_W = 3
NORM_EPS = 1e-6
NEG_INF = -1e30

A_Q_W = A_Q_HEADS * HEAD_DIM
A_KV_W = A_KV_HEADS * HEAD_DIM
B_W = B_HEADS * HEAD_DIM
C_K_W = C_HEADS * C_KEY_DIM
C_V_W = C_HEADS * C_VAL_DIM
IN_SPLITS = (A_Q_W, A_KV_W, A_KV_W, B_W, B_W, B_W, C_K_W, C_V_W, C_K_W, C_V_W, D_MODEL, D_MODEL, D_MODEL)
IN_W = sum(IN_SPLITS)
IN_OFFSETS = tuple(int(o) for o in np.cumsum(IN_SPLITS)[:-1])

kernel_name = 'hybrid_stream_swa_band_hgrn2_convffn_step'


def _rmsnorm(x, g):
    xf = x.astype(jnp.float32)
    y = xf * lax.rsqrt(jnp.mean(xf * xf, axis=-1, keepdims=True) + NORM_EPS)
    return (y * g.astype(jnp.float32)).astype(x.dtype)


def _rope(x, pos):
    half = ROPE_DIM // 2
    inv_freq = ROPE_THETA ** (-jnp.arange(0, ROPE_DIM, 2, dtype=jnp.float32) / ROPE_DIM)
    ang = pos.astype(jnp.float32)[:, None] * inv_freq[None, :]
    cos = jnp.cos(ang)[None, :, None, :]
    sin = jnp.sin(ang)[None, :, None, :]
    xr = x[..., :ROPE_DIM].astype(jnp.float32)
    x1, x2 = xr[..., :half], xr[..., half:]
    rot = jnp.concatenate([x1 * cos - x2 * sin, x2 * cos + x1 * sin], axis=-1)
    return jnp.concatenate([rot.astype(x.dtype), x[..., ROPE_DIM:]], axis=-1)


def _chunk_band(x, prev):
    b, t, h, d = x.shape
    nc = t // CHUNK
    xc = x.reshape(b, nc, CHUNK, h, d)
    xp = jnp.pad(xc, ((0, 0), (prev, 0), (0, 0), (0, 0), (0, 0)))
    band = jnp.stack([xp[:, m:m + nc] for m in range(prev + 1)], axis=2)
    return band.reshape(b, nc, (prev + 1) * CHUNK, h, d)


def _band_valid(nc, prev):
    src = jnp.arange(nc)[:, None] - prev + jnp.arange(prev + 1)[None, :]
    return jnp.repeat(src >= 0, CHUNK, axis=1)


def _softmax_with_sink(s, sink):
    sink_col = jnp.broadcast_to(sink, s.shape[:-1] + (1,))
    p = jax.nn.softmax(jnp.concatenate([s, sink_col], axis=-1), axis=-1)
    return p[..., :-1]


def _rel_bias(table, rel):
    idx = jnp.clip(rel, -REL_CLIP, REL_CLIP) + REL_CLIP
    return table[:, idx].astype(jnp.float32)


def _swa_prompt(q, k, v, sinks):
    b, t = q.shape[:2]
    nc = t // CHUNK
    qc = q.reshape(b, nc, CHUNK, A_KV_HEADS, A_GROUP, HEAD_DIM)
    kb = _chunk_band(k, A_PREV_CHUNKS)
    vb = _chunk_band(v, A_PREV_CHUNKS)
    s = jnp.einsum('bnqhgd,bnkhd->bnhgqk', qc, kb).astype(jnp.float32) * (HEAD_DIM ** -0.5)
    valid = _band_valid(nc, A_PREV_CHUNKS)
    s = jnp.where(valid[None, :, None, None, None, :], s, NEG_INF)
    p = _softmax_with_sink(s, sinks.astype(jnp.float32).reshape(A_KV_HEADS, A_GROUP, 1, 1))
    o = jnp.einsum('bnhgqk,bnkhd->bnqhgd', p.astype(v.dtype), vb)
    return o.reshape(b, t, A_Q_W)


def _swa_step(q, k, v, k_cache, v_cache, sinks):
    b, t = q.shape[:2]
    kk = jnp.concatenate([k_cache.astype(k.dtype), k], axis=1)
    vv = jnp.concatenate([v_cache.astype(v.dtype), v], axis=1)
    qg = q.reshape(b, t, A_KV_HEADS, A_GROUP, HEAD_DIM)
    s = jnp.einsum('bqhgd,bkhd->bhgqk', qg, kk).astype(jnp.float32) * (HEAD_DIM ** -0.5)
    p = _softmax_with_sink(s, sinks.astype(jnp.float32).reshape(A_KV_HEADS, A_GROUP, 1, 1))
    o = jnp.einsum('bhgqk,bkhd->bqhgd', p.astype(v.dtype), vv)
    return o.reshape(b, t, A_Q_W), kk[:, t:], vv[:, t:]


def _band_prompt(q, k, v, rel_table):
    b, t = q.shape[:2]
    nc = t // CHUNK
    width = (B_PREV_CHUNKS + 1) * CHUNK
    qc = q.reshape(b, nc, CHUNK, B_HEADS, HEAD_DIM)
    kb = _chunk_band(k, B_PREV_CHUNKS)
    vb = _chunk_band(v, B_PREV_CHUNKS)
    rel = B_REACH + jnp.arange(CHUNK)[:, None] - jnp.arange(width)[None, :]
    bias = _rel_bias(rel_table, rel)
    s = jnp.einsum('bnqhd,bnkhd->bnhqk', qc, kb).astype(jnp.float32) * (HEAD_DIM ** -0.5) + bias[None, None]
    valid = _band_valid(nc, B_PREV_CHUNKS)
    s = jnp.where(valid[None, :, None, None, :], s, NEG_INF)
    p = jax.nn.softmax(s, axis=-1)
    o = jnp.einsum('bnhqk,bnkhd->bnqhd', p.astype(v.dtype), vb)
    return o.reshape(b, t, B_W)


def _band_step(q, k, v, k_cache, v_cache, rel_table):
    b, t = q.shape[:2]
    r = k_cache.shape[1]
    kk = jnp.concatenate([k_cache.astype(k.dtype), k], axis=1)
    vv = jnp.concatenate([v_cache.astype(v.dtype), v], axis=1)
    rel = (r + jnp.arange(t))[:, None] - jnp.arange(r + t)[None, :]
    bias = _rel_bias(rel_table, rel)
    s = jnp.einsum('bqhd,bkhd->bhqk', q, kk).astype(jnp.float32) * (HEAD_DIM ** -0.5) + bias[None]
    p = jax.nn.softmax(s, axis=-1)
    o = jnp.einsum('bhqk,bkhd->bqhd', p.astype(v.dtype), vv)
    return o.reshape(b, t, B_W), kk[:, t:], vv[:, t:]


def _hgrn2_scan(log_f, k, v, q, s0):
    b, t, h, dk = k.shape
    dv = v.shape[-1]
    pad = (-t) % REC_BLOCK
    n = (t + pad) // REC_BLOCK

    def blocks(a):
        a = jnp.pad(a, ((0, 0), (0, pad), (0, 0), (0, 0)))
        return a.reshape(b, n, REC_BLOCK, h, a.shape[-1]).transpose(1, 0, 3, 2, 4)

    lf, kk, vv, qq = blocks(log_f), blocks(k), blocks(v), blocks(q)
    cum = jnp.cumsum(lf, axis=3)
    last = cum[:, :, :, -1:, :]
    causal = jnp.tril(jnp.ones((REC_BLOCK, REC_BLOCK), dtype=bool))[:, :, None]
    diff = cum[:, :, :, :, None, :] - cum[:, :, :, None, :, :]
    decay = jnp.where(causal, jnp.exp(jnp.where(causal, diff, 0.0)), 0.0)
    scores = jnp.einsum('nbhtk,nbhsk,nbhtsk->nbhts', qq, kk, decay)
    o_intra = jnp.einsum('nbhts,nbhsv->nbhtv', scores, vv)
    q_dec = qq * jnp.exp(cum)
    k_dec = kk * jnp.exp(last - cum)
    blk_decay = jnp.exp(last[:, :, :, 0, :])

    def step(state, xs):
        qd, kd, vb, dec = xs
        o = jnp.einsum('bhtk,bhkv->bhtv', qd, state)
        state = dec[..., None] * state + jnp.einsum('bhtk,bhtv->bhkv', kd, vb)
        return state, o

    s_fin, o_inter = lax.scan(step, s0, (q_dec, k_dec, vv, blk_decay))
    o = (o_intra + o_inter).transpose(1, 0, 3, 2, 4).reshape(b, n * REC_BLOCK, h, dv)
    return o[:, :t], s_fin


def _hgrn2_branch(f_pre, i_in, q_pre, og, lb, c_norm, s0):
    f32 = jnp.float32
    b, t = f_pre.shape[:2]
    shp_k = (b, t, C_HEADS, C_KEY_DIM)
    lbh = lb.astype(f32).reshape(C_HEADS, C_KEY_DIM)
    z = f_pre.astype(f32).reshape(shp_k)
    log_f = jnp.logaddexp(jnp.log(lbh), jnp.log1p(-lbh) + jax.nn.log_sigmoid(z))
    k = -jnp.expm1(log_f)
    q = jax.nn.silu(q_pre.astype(f32)).reshape(shp_k)
    v = i_in.astype(f32).reshape(b, t, C_HEADS, C_VAL_DIM)
    o, s_fin = _hgrn2_scan(log_f, k, v, q, s0.astype(f32))
    o = o * lax.rsqrt(jnp.mean(o * o, axis=-1, keepdims=True) + NORM_EPS)
    o = o * c_norm.astype(f32).reshape(C_HEADS, C_VAL_DIM)
    o = o.reshape(b, t, C_V_W) * jax.nn.silu(og.astype(f32))
    return o.astype(f_pre.dtype), s_fin


def _layer(x, pos, lw, cache):
    (norm1, w_in, sinks, rel_table, lb, c_norm, wa, wb, wc, w_out,
     norm2, w_up, w_conv, b_conv, w_down) = lw
    b, t, _ = x.shape
    h = _rmsnorm(x, norm1)
    aq, ak, av, bq, bk, bv, cf, ci, cq, cog, ga, gb, gc = jnp.split(h @ w_in, IN_OFFSETS, axis=-1)
    aq = _rope(aq.reshape(b, t, A_Q_HEADS, HEAD_DIM), pos)
    ak = _rope(ak.reshape(b, t, A_KV_HEADS, HEAD_DIM), pos)
    av = av.reshape(b, t, A_KV_HEADS, HEAD_DIM)
    bq = bq.reshape(b, t, B_HEADS, HEAD_DIM)
    bk = bk.reshape(b, t, B_HEADS, HEAD_DIM)
    bv = bv.reshape(b, t, B_HEADS, HEAD_DIM)
    if cache is None:
        oa = _swa_prompt(aq, ak, av, sinks)
        ra = min(A_WINDOW, t)
        na_k, na_v = ak[:, t - ra:], av[:, t - ra:]
        ob = _band_prompt(bq, bk, bv, rel_table)
        rb = min(B_REACH, t)
        nb_k, nb_v = bk[:, t - rb:], bv[:, t - rb:]
        s0 = jnp.zeros((b, C_HEADS, C_KEY_DIM, C_VAL_DIM), jnp.float32)
        conv_prev = jnp.zeros((b, CONV_W - 1, 2 * D_FF), x.dtype)
    else:
        ca_k, ca_v, cb_k, cb_v, s0, conv_prev = cache
        oa, na_k, na_v = _swa_step(aq, ak, av, ca_k, ca_v, sinks)
        ob, nb_k, nb_v = _band_step(bq, bk, bv, cb_k, cb_v, rel_table)
    oc, nc_state = _hgrn2_branch(cf, ci, cq, cog, lb, c_norm, s0)
    mix = (jax.nn.sigmoid(ga) * (oa @ wa)
           + jax.nn.sigmoid(gb) * (ob @ wb)
           + jax.nn.sigmoid(gc) * (oc @ wc))
    x = x + mix @ w_out
    h2 = _rmsnorm(x, norm2)
    up = h2 @ w_up
    ext = jnp.concatenate([conv_prev.astype(up.dtype), up], axis=1)
    conv = b_conv
    for j in range(CONV_W):
        conv = conv + ext[:, j:j + t] * w_conv[j]
    u, g = jnp.split(conv, 2, axis=-1)
    x = x + (u * jax.nn.gelu(g)) @ w_down
    new_conv = ext[:, t:]
    return x, (na_k, na_v, nb_k, nb_v, nc_state, new_conv)


def setup_inputs(seed: int = 0) -> dict:
    key = jax.random.key(seed)
    ks = jax.random.split(key, 26)
    f32 = jnp.float32

    def nrm(k, shape, scale):
        return jax.random.normal(k, shape, f32) * scale

    ra = min(A_WINDOW, PAST_LEN)
    rb = min(B_REACH, PAST_LEN)
    return {
        'x_prompt': nrm(ks[0], (BATCH, SEQ, D_MODEL), 1.0),
        'x_sample': nrm(ks[1], (DEC_BATCH, DEC_SEQ, D_MODEL), 1.0),
        'cache_a_k': nrm(ks[2], (DEPTH, DEC_BATCH, ra, A_KV_HEADS, HEAD_DIM), 1.0),
        'cache_a_v': nrm(ks[3], (DEPTH, DEC_BATCH, ra, A_KV_HEADS, HEAD_DIM), 1.0),
        'cache_b_k': nrm(ks[4], (DEPTH, DEC_BATCH, rb, B_HEADS, HEAD_DIM), 1.0),
        'cache_b_v': nrm(ks[5], (DEPTH, DEC_BATCH, rb, B_HEADS, HEAD_DIM), 1.0),
        'state_c': nrm(ks[6], (DEPTH, DEC_BATCH, C_HEADS, C_KEY_DIM, C_VAL_DIM), 0.3),
        'state_ffn_conv': nrm(ks[7], (DEPTH, DEC_BATCH, CONV_W - 1, 2 * D_FF), 1.0),
        'norm1': 1.0 + nrm(ks[8], (DEPTH, D_MODEL), 0.02),
        'w_in': nrm(ks[9], (DEPTH, D_MODEL, IN_W), D_MODEL ** -0.5),
        'a_sinks': nrm(ks[10], (DEPTH, A_Q_HEADS), 0.5),
        'b_rel_bias': nrm(ks[11], (DEPTH, B_HEADS, 2 * REL_CLIP + 1), 0.2),
        'c_lb_logits': nrm(ks[12], (DEPTH, C_K_W), 0.5),
        'c_norm': 1.0 + nrm(ks[13], (DEPTH, C_V_W), 0.02),
        'w_branch_a': nrm(ks[14], (DEPTH, A_Q_W, D_MODEL), A_Q_W ** -0.5),
        'w_branch_b': nrm(ks[15], (DEPTH, B_W, D_MODEL), B_W ** -0.5),
        'w_branch_c': nrm(ks[16], (DEPTH, C_V_W, D_MODEL), C_V_W ** -0.5),
        'w_out': nrm(ks[17], (DEPTH, D_MODEL, D_MODEL), D_MODEL ** -0.5),
        'norm2': 1.0 + nrm(ks[18], (DEPTH, D_MODEL), 0.02),
        'w_up': nrm(ks[19], (DEPTH, D_MODEL, 2 * D_FF), D_MODEL ** -0.5),
        'w_conv': nrm(ks[20], (DEPTH, CONV_W, 2 * D_FF), CONV_W ** -0.5),
        'b_conv': nrm(ks[21], (DEPTH, 2 * D_FF), 0.02),
        'w_down': nrm(ks[22], (DEPTH, D_FF, D_MODEL), D_FF ** -0.5),
        'norm_final': 1.0 + nrm(ks[23], (D_MODEL,), 0.02),
    }


def reference(x_prompt, x_sample, cache_a_k, cache_a_v, cache_b_k, cache_b_v, state_c, state_ffn_conv,
              norm1, w_in, a_sinks, b_rel_bias, c_lb_logits, c_norm, w_branch_a, w_branch_b, w_branch_c,
              w_out, norm2, w_up, w_conv, b_conv, w_down, norm_final):
    lb_cum = jnp.cumsum(jax.nn.softmax(c_lb_logits.astype(jnp.float32), axis=0), axis=0)
    lower_bounds = lb_cum - lb_cum[0:1]
    pos_p = jnp.arange(x_prompt.shape[1], dtype=jnp.int32)
    pos_s = PAST_LEN + jnp.arange(x_sample.shape[1], dtype=jnp.int32)
    xp, xs = x_prompt, x_sample
    st_p, st_s = [], []
    for l in range(DEPTH):
        lw = (norm1[l], w_in[l], a_sinks[l], b_rel_bias[l], lower_bounds[l], c_norm[l],
              w_branch_a[l], w_branch_b[l], w_branch_c[l], w_out[l], norm2[l], w_up[l],
              w_conv[l], b_conv[l], w_down[l])
        xp, sp = _layer(xp, pos_p, lw, None)
        xs, ss = _layer(xs, pos_s, lw, (cache_a_k[l], cache_a_v[l], cache_b_k[l], cache_b_v[l],
                                        state_c[l], state_ffn_conv[l]))
        st_p.append(sp)
        st_s.append(ss)
    y_prompt = _rmsnorm(xp, norm_final)
    y_sample = _rmsnorm(xs, norm_final)

    def stk(sts, i):
        return jnp.stack([s[i] for s in sts], axis=0)

    return (y_prompt, y_sample,
            stk(st_p, 0), stk(st_p, 1), stk(st_p, 2), stk(st_p, 3), stk(st_p, 4), stk(st_p, 5),
            stk(st_s, 0), stk(st_s, 1), stk(st_s, 2), stk(st_s, 3), stk(st_s, 4), stk(st_s, 5))
```

```cpp
#include <hip/hip_runtime.h>
#include <hip/hip_cooperative_groups.h>
#include <cstdio>
namespace cg = cooperative_groups;

typedef unsigned short u16;
using bf16x8 = __attribute__((ext_vector_type(8))) short;
using f32x4 = __attribute__((ext_vector_type(4))) float;
#define DI __device__ __forceinline__
#define MFMA16(a, b, c) __builtin_amdgcn_mfma_f32_16x16x32_bf16((a), (b), (c), 0, 0, 0)

#ifndef PHM
#define PHM 0xFFFF
#endif
#ifndef USE_CG_SYNC
#define USE_CG_SYNC 1
#endif

constexpr int DM = 1024, TP = 16384, TS = 512, T = TP + TS, NBATCH = 8;
constexpr int INW = 7424, NIN1 = 4352;
constexpr int DFF = 2816, DFF2 = 5632;
constexpr int KA_ROWS = TP + NBATCH * 192, KB_ROWS = TP + NBATCH * 576;
constexpr int NT = 256;
constexpr float EPS = 1e-6f;
constexpr int LDS_BYTES = 73728 + 1024;

constexpr size_t OFF_BAR   = 0;
constexpr size_t OFF_ROWSQ1 = 16384;
constexpr size_t OFF_ROWSQ2 = OFF_ROWSQ1 + 67584;
constexpr size_t OFF_DECAY = OFF_ROWSQ2 + 67584;
constexpr size_t OFF_WMIX  = OFF_DECAY + 262144;
constexpr size_t W_IN_B = (size_t)INW * 1024 * 2, W_BR_B = (size_t)1024 * 512 * 2, W_OUT_B = (size_t)1024 * 1024 * 2;
constexpr size_t OFF_WIN = OFF_WMIX, OFF_WA = OFF_WIN + W_IN_B, OFF_WB = OFF_WA + W_BR_B, OFF_WC = OFF_WB + W_BR_B, OFF_WOUT = OFF_WC + W_BR_B;
constexpr size_t OFF_XB    = OFF_WOUT + W_OUT_B;
constexpr size_t OFF_ST    = OFF_XB + (size_t)T * 1024 * 2;
constexpr size_t OFF_WUP = OFF_ST, OFF_WDOWN = OFF_ST + (size_t)DFF2 * 1024 * 2;
constexpr size_t OFF_QA    = OFF_ST + (size_t)128 * 4 * 16384 * 4;
constexpr size_t PLANE = (size_t)T * 512 * 2;
constexpr size_t OFF_QB    = OFF_QA + PLANE;
constexpr size_t OFF_KA    = OFF_QB + PLANE;
constexpr size_t OFF_VTA   = OFF_KA + (size_t)KA_ROWS * 128 * 2;
constexpr size_t OFF_KB    = OFF_VTA + (size_t)KA_ROWS * 128 * 2;
constexpr size_t OFF_VTB   = OFF_KB + (size_t)KB_ROWS * 512 * 2;
constexpr size_t OFF_HF    = OFF_VTB + (size_t)KB_ROWS * 512 * 2;
constexpr size_t OFF_HI = OFF_HF + PLANE, OFF_HQ = OFF_HI + PLANE, OFF_HOG = OFF_HQ + PLANE;
constexpr size_t WS_END = OFF_HOG + PLANE;
constexpr size_t OFF_MIX = OFF_HF;
constexpr size_t OFF_ACT = OFF_QA;
static_assert(OFF_ACT + (size_t)T * DFF * 2 <= WS_END, "act fits");

constexpr size_t O_X = 0;
constexpr size_t O_AKP = (size_t)T * 1024;
constexpr size_t O_AVP = O_AKP + 32768;
constexpr size_t O_BKP = O_AVP + 32768;
constexpr size_t O_BVP = O_BKP + 524288;
constexpr size_t O_CP  = O_BVP + 524288;
constexpr size_t O_CVP = O_CP + 131072;
constexpr size_t O_AKS = O_CVP + 22528;
constexpr size_t O_AVS = O_AKS + 262144;
constexpr size_t O_BKS = O_AVS + 262144;
constexpr size_t O_BVS = O_BKS + 4194304;
constexpr size_t O_CS  = O_BVS + 4194304;
constexpr size_t O_CVS = O_CS + 1048576;
constexpr size_t O_END = O_CVS + 180224;

struct Params { const float* in[24]; float* out; unsigned char* ws; };

DI u16 f2bf(float x) { unsigned u = __float_as_uint(x); u += 0x7fffu + ((u >> 16) & 1u); return (u16)(u >> 16); }
DI float bf2f(u16 v) { return __uint_as_float(((unsigned)v) << 16); }
DI unsigned pack2(float a, float b) { return (unsigned)f2bf(a) | ((unsigned)f2bf(b) << 16); }
DI float lo_f(unsigned u) { return __uint_as_float(u << 16); }
DI float hi_f(unsigned u) { return __uint_as_float(u & 0xffff0000u); }
DI float wave_sum(float v) {
#pragma unroll
  for (int o = 32; o >= 1; o >>= 1) v += __shfl_xor(v, o, 64);
  return v;
}
DI int tidx() { int t = threadIdx.x; asm volatile("" : "+v"(t)); return t; }
DI float sigmoidf_(float x) { return 1.f / (1.f + __expf(-x)); }
DI int krowA(int tok) { if (tok < TP) return tok; int s = tok - TP; return TP + (s >> 6) * 192 + 128 + (s & 63); }
DI int krowB(int tok) { if (tok < TP) return tok; int s = tok - TP; return TP + (s >> 6) * 576 + 512 + (s & 63); }

#define XB_TMO      128
#define XB_XCNT(j)  (256  + 64 * (j))
#define XB_XSUB(j)  (1280 + 64 * (j))
#define XB_XGEN(j)  (2304 + 64 * (j))
#define XB_TOP      3328
#define XB_TOPGEN   3392
#define XCD_BAR_WORDS 3456
#define XB_SPIN_CAP (1u << 24)
#define LAS __attribute__((address_space(3)))
DI unsigned xb_ld(unsigned* p) { return __hip_atomic_load(p, __ATOMIC_RELAXED, __HIP_MEMORY_SCOPE_AGENT); }
DI unsigned xb_add(unsigned* p, unsigned v) { return __hip_atomic_fetch_add(p, v, __ATOMIC_RELAXED, __HIP_MEMORY_SCOPE_AGENT); }
DI unsigned xb_xcc_id() { return (unsigned)__builtin_amdgcn_s_getreg((3 << 11) | 20) & 0xFu; }
#define XB_SPIN(cond, bar) do { unsigned _sp = 0; while (cond) { __builtin_amdgcn_s_sleep(1); \
    if ((++_sp & 255u) == 0u) { if (xb_ld(&(bar)[XB_TMO])) break; if (_sp > XB_SPIN_CAP) { atomicAdd(&(bar)[XB_TMO], 1u); break; } } } } while (0)
struct XcdBarrier { unsigned* bar; unsigned x; volatile LAS unsigned* st; };
DI XcdBarrier xcd_barrier_post(unsigned* bar, volatile LAS unsigned* st) {
  XcdBarrier b; b.bar = bar; b.x = xb_xcc_id(); b.st = st;
  if (threadIdx.x == 0) (void)xb_add(&bar[XB_XCNT(b.x)], 1u);
  return b;
}
DI void xcd_barrier_complete(unsigned* bar, unsigned x, unsigned& nloc, unsigned& nx) {
  const unsigned G = gridDim.x;
  unsigned sum, cnt, mine, sp = 0u;
  for (;;) {
    sum = 0u; cnt = 0u; mine = 0u;
#pragma unroll
    for (unsigned j = 0; j < 16; ++j) { const unsigned c = xb_ld(&bar[XB_XCNT(j)]); sum += c; cnt += (c > 0u) ? 1u : 0u; mine = (j == x) ? c : mine; }
    if (sum == G) break;
    __builtin_amdgcn_s_sleep(1);
    if ((++sp & 255u) == 0u) { if (xb_ld(&bar[XB_TMO])) break; if (sp > XB_SPIN_CAP) { atomicAdd(&bar[XB_TMO], 1u); break; } }
  }
  nloc = mine > 0u ? mine : 1u; nx = cnt > 0u ? cnt : 1u;
}
DI void xcd_barrier(const XcdBarrier& b) {
  asm volatile("s_waitcnt vmcnt(0)" ::: "memory");
  __syncthreads();
  if (threadIdx.x == 0) {
    unsigned* bar = b.bar;
    __builtin_amdgcn_s_waitcnt(0);
    unsigned nloc = b.st[0], nx = b.st[1];
    if (nloc == 0u) { xcd_barrier_complete(bar, b.x, nloc, nx); b.st[0] = nloc; b.st[1] = nx; }
    const unsigned old = xb_add(&bar[XB_XSUB(b.x)], 1u);
    const unsigned gen = old / nloc;
    if (old + 1u == (gen + 1u) * nloc) {
      __builtin_amdgcn_fence(__ATOMIC_RELEASE, "agent");
      asm volatile("s_waitcnt vmcnt(0)" ::: "memory");
      const unsigned og = xb_add(&bar[XB_TOP], 1u);
      const unsigned tg = og / nx;
      if (og + 1u == (tg + 1u) * nx) xb_add(&bar[XB_TOPGEN], 1u);
      else XB_SPIN(xb_ld(&bar[XB_TOPGEN]) == tg, bar);
      __builtin_amdgcn_fence(__ATOMIC_ACQUIRE, "agent");
      xb_add(&bar[XB_XGEN(b.x)], 1u);
      asm volatile("s_waitcnt vmcnt(0)" ::: "memory");
    } else {
      XB_SPIN(xb_ld(&bar[XB_XGEN(b.x)]) == gen, bar);
      __builtin_amdgcn_fence(__ATOMIC_ACQUIRE, "agent");
      asm volatile("s_waitcnt vmcnt(0)" ::: "memory");
    }
  }
  __syncthreads();
}

template <int NB>
DI void gemm_tile(f32x4 (&acc)[4][NB], const u16* __restrict__ A, int lda, int row0, int lo, int hi,
                  const u16* __restrict__ W, int ldw, int K, char* smem) {
  const int tid = tidx(), lane = tid & 63, wid = tid >> 6, wr = wid >> 1, wc = wid & 1, fr = lane & 15, fq = lane >> 4;
  const int sr = tid >> 3, sc = tid & 7;
  uint4 ra0, ra1, ra2, ra3, rb0, rb1, rb2, rb3;
  rb0 = rb1 = rb2 = rb3 = make_uint4(0u, 0u, 0u, 0u);
#pragma unroll
  for (int m = 0; m < 4; ++m)
#pragma unroll
    for (int n = 0; n < NB; ++n) acc[m][n] = f32x4{0.f, 0.f, 0.f, 0.f};
  const int g0 = row0 + sr;
  const unsigned ma0 = (g0 >= lo && g0 < hi) ? 0xffffffffu : 0u, ma1 = (g0 + 32 >= lo && g0 + 32 < hi) ? 0xffffffffu : 0u;
  const unsigned ma2 = (g0 + 64 >= lo && g0 + 64 < hi) ? 0xffffffffu : 0u, ma3 = (g0 + 96 >= lo && g0 + 96 < hi) ? 0xffffffffu : 0u;
  const int c0r = min(max(g0, lo), hi - 1), c1r = min(max(g0 + 32, lo), hi - 1), c2r = min(max(g0 + 64, lo), hi - 1), c3r = min(max(g0 + 96, lo), hi - 1);
  const u16* ap0 = A + (size_t)c0r * lda + sc * 8;
  const u16* ap1 = A + (size_t)c1r * lda + sc * 8;
  const u16* ap2 = A + (size_t)c2r * lda + sc * 8;
  const u16* ap3 = A + (size_t)c3r * lda + sc * 8;
  const u16* wp = W + (size_t)sr * ldw + sc * 8;
  const size_t ws32 = (size_t)32 * ldw;
  int koff = 0;
  char* sw = smem + sr * 144 + sc * 16;
#define MSK(r, m) do { r.x &= m; r.y &= m; r.z &= m; r.w &= m; } while (0)
#define GLOAD() do { \
    ra0 = *(const uint4*)(ap0 + koff); ra1 = *(const uint4*)(ap1 + koff); ra2 = *(const uint4*)(ap2 + koff); ra3 = *(const uint4*)(ap3 + koff); \
    MSK(ra0, ma0); MSK(ra1, ma1); MSK(ra2, ma2); MSK(ra3, ma3); \
    rb0 = *(const uint4*)(wp + koff); rb1 = *(const uint4*)(wp + ws32 + koff); \
    if (NB > 2) { rb2 = *(const uint4*)(wp + 2 * ws32 + koff); rb3 = *(const uint4*)(wp + 3 * ws32 + koff); } \
    koff += 64; } while (0)
#define SWRITE(buf) do { char* b_ = sw + (buf) * 36864; \
    *(uint4*)(b_) = ra0; *(uint4*)(b_ + 32 * 144) = ra1; *(uint4*)(b_ + 64 * 144) = ra2; *(uint4*)(b_ + 96 * 144) = ra3; \
    *(uint4*)(b_ + 18432) = rb0; *(uint4*)(b_ + 18432 + 32 * 144) = rb1; \
    if (NB > 2) { *(uint4*)(b_ + 18432 + 64 * 144) = rb2; *(uint4*)(b_ + 18432 + 96 * 144) = rb3; } } while (0)
  GLOAD(); SWRITE(0); __syncthreads();
  const int nk = K >> 6;
  for (int kt = 0; kt < nk; ++kt) {
    if (kt + 1 < nk) GLOAD();
    const char* b = smem + (kt & 1) * 36864;
#pragma unroll
    for (int kk = 0; kk < 2; ++kk) {
      bf16x8 af[4], bfr[NB];
#pragma unroll
      for (int m = 0; m < 4; ++m) af[m] = *(const bf16x8*)(b + (wr * 64 + m * 16 + fr) * 144 + (kk * 32 + fq * 8) * 2);
#pragma unroll
      for (int n = 0; n < NB; ++n) bfr[n] = *(const bf16x8*)(b + 18432 + (wc * (NB * 16) + n * 16 + fr) * 144 + (kk * 32 + fq * 8) * 2);
#pragma unroll
      for (int m = 0; m < 4; ++m)
#pragma unroll
        for (int n = 0; n < NB; ++n) acc[m][n] = MFMA16(af[m], bfr[n], acc[m][n]);
    }
    if (kt + 1 < nk) SWRITE((kt + 1) & 1);
    __syncthreads();
  }
#undef GLOAD
#undef SWRITE
#undef MSK
}

constexpr int CTS = 132;
template <int NB>
DI void acc_to_lds(const f32x4 (&acc)[4][NB], float* Ct, const float* rs) {
  const int tid = tidx(), lane = tid & 63, wid = tid >> 6, wr = wid >> 1, wc = wid & 1, fr = lane & 15, fq = lane >> 4;
#pragma unroll
  for (int m = 0; m < 4; ++m)
#pragma unroll
    for (int j = 0; j < 4; ++j) {
      const int r = wr * 64 + m * 16 + fq * 4 + j;
      const float s = rs ? rs[r] : 1.f;
#pragma unroll
      for (int n = 0; n < NB; ++n) Ct[r * CTS + wc * (NB * 16) + n * 16 + fr] = acc[m][n][j] * s;
    }
  __syncthreads();
}

DI void conv_wtile(const float* __restrict__ src, int K, int N, u16* __restrict__ dst, const float* __restrict__ gain, int permute, int tile, float* tl) {
  const int tid = tidx();
  const int nnt = N >> 6; const int kt = tile / nnt, nt = tile - kt * nnt; const int k0 = kt * 64, n0 = nt * 64;
  {
    const int n = tid & 63, kq = tid >> 6;
#pragma unroll 4
    for (int i = 0; i < 16; ++i) { const int k = i * 4 + kq; float v = src[(size_t)(k0 + k) * N + n0 + n]; if (gain) v *= gain[k0 + k]; tl[k * 65 + n] = v; }
  }
  __syncthreads();
#pragma unroll
  for (int j = 0; j < 2; ++j) {
    const int n = (tid >> 3) + 32 * j, ks = tid & 7;
    float v[8];
#pragma unroll
    for (int q = 0; q < 8; ++q) v[q] = tl[(ks * 8 + q) * 65 + n];
    int nn = n0 + n;
    if (permute) nn = (nn < DFF) ? ((nn >> 6) * 128 + (nn & 63)) : ((((nn - DFF) >> 6) * 128) + 64 + ((nn - DFF) & 63));
    uint4 pk = make_uint4(pack2(v[0], v[1]), pack2(v[2], v[3]), pack2(v[4], v[5]), pack2(v[6], v[7]));
    *(uint4*)(dst + (size_t)nn * K + k0 + ks * 8) = pk;
  }
  __syncthreads();
}
constexpr int NCONV_MIX = 1856 + 3 * 128 + 256;
constexpr int NCONV_FFN = 1408 + 704;
DI void conv_wmix_item(const Params& p, int l, int it, char* smem) {
  float* tl = (float*)smem; unsigned char* ws = p.ws;
  if (it < 1856) conv_wtile(p.in[9] + (size_t)l * 1024 * INW, 1024, INW, (u16*)(ws + OFF_WIN), p.in[8] + l * 1024, 0, it, tl);
  else if (it < 1856 + 384) { const int b = (it - 1856) >> 7, t = (it - 1856) & 127;
    conv_wtile(p.in[14 + b] + (size_t)l * 512 * 1024, 512, 1024, (u16*)(ws + OFF_WA + b * W_BR_B), nullptr, 0, t, tl); }
  else conv_wtile(p.in[17] + (size_t)l * 1024 * 1024, 1024, 1024, (u16*)(ws + OFF_WOUT), nullptr, 0, it - 2240, tl);
}
DI void conv_wffn_item(const Params& p, int l, int it, char* smem) {
  float* tl = (float*)smem; unsigned char* ws = p.ws;
  if (it < 1408) conv_wtile(p.in[19] + (size_t)l * 1024 * DFF2, 1024, DFF2, (u16*)(ws + OFF_WUP), p.in[18] + l * 1024, 1, it, tl);
  else conv_wtile(p.in[22] + (size_t)l * DFF * 1024, DFF, 1024, (u16*)(ws + OFF_WDOWN), nullptr, 0, it - 1408, tl);
}

DI void phase0(const Params& p, char* smem) {
  const int tid = tidx(), lane = tid & 63, wid = tid >> 6;
  float* x = p.out; u16* xb = (u16*)(p.ws + OFF_XB);
  float* rowsq1 = (float*)(p.ws + OFF_ROWSQ1); float* rowsq2 = (float*)(p.ws + OFF_ROWSQ2);
  for (int it = blockIdx.x; it < T / 4; it += gridDim.x) {
    const int row = it * 4 + wid;
    const float* src = row < TP ? p.in[0] + (size_t)row * 1024 : p.in[1] + (size_t)(row - TP) * 1024;
    float ss = 0.f;
#pragma unroll
    for (int i = 0; i < 4; ++i) {
      const int c = (i * 64 + lane) * 4;
      const float4 v = *(const float4*)(src + c);
      *(float4*)(x + (size_t)row * 1024 + c) = v;
      ss += v.x * v.x + v.y * v.y + v.z * v.z + v.w * v.w;
      *(uint2*)(xb + (size_t)row * 1024 + c) = make_uint2(pack2(v.x, v.y), pack2(v.z, v.w));
    }
    ss = wave_sum(ss);
    if (lane == 0) { rowsq1[row] = ss; rowsq2[row] = 0.f; }
  }
  for (int it = blockIdx.x; it < NCONV_MIX; it += gridDim.x) conv_wmix_item(p, 0, it, smem);
  const size_t gsz = (size_t)gridDim.x * NT, g0 = (size_t)blockIdx.x * NT + tid;
  for (size_t e = g0; e < (size_t)2 * 8 * 64 * 128; e += gsz) {
    const size_t lb = e / (64 * 128), r = e % (64 * 128);
    p.out[O_AKS + lb * 128 * 128 + r] = p.in[2][lb * 128 * 128 + 64 * 128 + r];
    p.out[O_AVS + lb * 128 * 128 + r] = p.in[3][lb * 128 * 128 + 64 * 128 + r];
  }
  for (size_t e = g0; e < (size_t)2 * 8 * 448 * 512 / 4; e += gsz) {
    const size_t e4 = e * 4; const size_t lb = e4 / (448 * 512), r = e4 % (448 * 512);
    *(float4*)(p.out + O_BKS + lb * 512 * 512 + r) = *(const float4*)(p.in[4] + lb * 512 * 512 + 64 * 512 + r);
    *(float4*)(p.out + O_BVS + lb * 512 * 512 + r) = *(const float4*)(p.in[5] + lb * 512 * 512 + 64 * 512 + r);
  }
}

DI void cache_to_kv(const Params& p, int l) {
  const int tid = tidx();
  const size_t gsz = (size_t)gridDim.x * NT, g0 = (size_t)blockIdx.x * NT + tid;
  u16* Ka = (u16*)(p.ws + OFF_KA); u16* Vta = (u16*)(p.ws + OFF_VTA); u16* Kb = (u16*)(p.ws + OFF_KB); u16* Vtb = (u16*)(p.ws + OFF_VTB);
  for (size_t e = g0; e < (size_t)8 * 128 * 128 / 8; e += gsz) {
    const size_t e8 = e * 8; const int b = (int)(e8 / (128 * 128)); const int j = (int)((e8 / 128) % 128), c = (int)(e8 % 128);
    const float* s = p.in[2] + ((size_t)(l * 8 + b) * 128 + j) * 128 + c;
    const float4 v0 = *(const float4*)s, v1 = *(const float4*)(s + 4);
    *(uint4*)(Ka + (size_t)(TP + b * 192 + j) * 128 + c) = make_uint4(pack2(v0.x, v0.y), pack2(v0.z, v0.w), pack2(v1.x, v1.y), pack2(v1.z, v1.w));
  }
  for (size_t e = g0; e < (size_t)8 * 512 * 512 / 8; e += gsz) {
    const size_t e8 = e * 8; const int b = (int)(e8 / (512 * 512)); const int j = (int)((e8 / 512) % 512), c = (int)(e8 % 512);
    const float* s = p.in[4] + ((size_t)(l * 8 + b) * 512 + j) * 512 + c;
    const float4 v0 = *(const float4*)s, v1 = *(const float4*)(s + 4);
    *(uint4*)(Kb + (size_t)(TP + b * 576 + j) * 512 + c) = make_uint4(pack2(v0.x, v0.y), pack2(v0.z, v0.w), pack2(v1.x, v1.y), pack2(v1.z, v1.w));
  }
  for (size_t e = g0; e < (size_t)8 * 16 * 128; e += gsz) {
    const int c = (int)(e % 128), j8 = (int)((e / 128) % 16), b = (int)(e / (128 * 16));
    const float* s = p.in[3] + ((size_t)(l * 8 + b) * 128 + j8 * 8) * 128 + c;
    float v[8];
#pragma unroll
    for (int q = 0; q < 8; ++q) v[q] = s[(size_t)q * 128];
    *(uint4*)(Vta + (size_t)c * KA_ROWS + TP + b * 192 + j8 * 8) = make_uint4(pack2(v[0], v[1]), pack2(v[2], v[3]), pack2(v[4], v[5]), pack2(v[6], v[7]));
  }
  for (size_t e = g0; e < (size_t)8 * 64 * 512; e += gsz) {
    const int c = (int)(e % 512), j8 = (int)((e / 512) % 64), b = (int)(e / (512 * 64));
    const float* s = p.in[5] + ((size_t)(l * 8 + b) * 512 + j8 * 8) * 512 + c;
    float v[8];
#pragma unroll
    for (int q = 0; q < 8; ++q) v[q] = s[(size_t)q * 512];
    *(uint4*)(Vtb + (size_t)c * KB_ROWS + TP + b * 576 + j8 * 8) = make_uint4(pack2(v[0], v[1]), pack2(v[2], v[3]), pack2(v[4], v[5]), pack2(v[6], v[7]));
  }
}

DI void p1_tile(const Params& p, int l, int rt, int ct, char* smem) {
  const int tid = tidx();
  unsigned char* ws = p.ws;
  float* Ct = (float*)smem; float* rs = (float*)(smem + 73728);
  const float* rowsq1 = (const float*)(ws + OFF_ROWSQ1);
  const int row0 = rt * 128;
  if (tid < 128) rs[tid] = rsqrtf(rowsq1[row0 + tid] * (1.f / 1024.f) + EPS);
  f32x4 acc[4][4];
  gemm_tile<4>(acc, (const u16*)(ws + OFF_XB), 1024, row0, 0, T, (const u16*)(ws + OFF_WIN) + (size_t)ct * 128 * 1024, 1024, 1024, smem);
  acc_to_lds<4>(acc, Ct, rs);
  int kind, cb;
  u16* dst; int dstw;
  bool isB = false; int hplane = 0;
  if (ct < 4)       { kind = 0; cb = ct * 128;        dst = (u16*)(ws + OFF_QA); dstw = 512; }
  else if (ct == 4) { kind = 1; cb = 0;               dst = (u16*)(ws + OFF_KA); dstw = 128; }
  else if (ct == 5) { kind = 2; cb = 0;               dst = (u16*)(ws + OFF_VTA); dstw = 128; }
  else if (ct < 10) { kind = 3; cb = (ct - 6) * 128;  dst = (u16*)(ws + OFF_QB); dstw = 512; isB = true; }
  else if (ct < 14) { kind = 4; cb = (ct - 10) * 128; dst = (u16*)(ws + OFF_KB); dstw = 512; isB = true; }
  else if (ct < 18) { kind = 2; cb = (ct - 14) * 128; dst = (u16*)(ws + OFF_VTB); dstw = 512; isB = true; }
  else { kind = 3; hplane = (ct - 18) >> 2; cb = ((ct - 18) & 3) * 128; dst = (u16*)(ws + OFF_HF + (size_t)hplane * PLANE); dstw = 512; }
  const bool rope = (kind == 0 || kind == 1);
  const bool iskv = (kind == 1 || kind == 2 || kind == 4);
  const int R = isB ? 512 : 128;
  float* cache_p = nullptr; float* cache_s = nullptr;
  if (iskv) {
    const bool isv = (kind == 2);
    cache_p = p.out + (isB ? (isv ? O_BVP : O_BKP) : (isv ? O_AVP : O_AKP)) + (size_t)l * R * dstw;
    cache_s = p.out + (isB ? (isv ? O_BVS : O_BKS) : (isv ? O_AVS : O_AKS)) + (size_t)l * 8 * R * dstw;
  }
#pragma unroll 1
  for (int i = 0; i < 4; ++i) {
    const int item = tid + NT * i; const int r = item >> 3, g = item & 7;
    const int tok = row0 + r;
    float v[16];
#pragma unroll
    for (int q = 0; q < 4; ++q) { const float4 t4 = *(const float4*)(Ct + r * CTS + g * 16 + q * 4); v[q * 4] = t4.x; v[q * 4 + 1] = t4.y; v[q * 4 + 2] = t4.z; v[q * 4 + 3] = t4.w; }
    if (rope && (g & 3) == 0) {
      const float pos = (float)(tok < TP ? tok : 1024 + ((tok - TP) & 63));
#pragma unroll
      for (int d = 0; d < 8; ++d) {
        const float invf = exp2f(-(float)d * (18.931568569324174f / 8.f));
        float sn, cs; sincosf(pos * invf, &sn, &cs);
        const float x1 = v[d], x2 = v[d + 8];
        v[d] = x1 * cs - x2 * sn; v[d + 8] = x2 * cs + x1 * sn;
      }
    }
    const int col = cb + g * 16;
    if (kind != 2) {
      size_t drow;
      if (kind == 1) drow = (size_t)krowA(tok); else if (kind == 4) drow = (size_t)krowB(tok); else drow = (size_t)tok;
      u16* d = dst + drow * dstw + col;
      *(uint4*)d = make_uint4(pack2(v[0], v[1]), pack2(v[2], v[3]), pack2(v[4], v[5]), pack2(v[6], v[7]));
      *(uint4*)(d + 8) = make_uint4(pack2(v[8], v[9]), pack2(v[10], v[11]), pack2(v[12], v[13]), pack2(v[14], v[15]));
    }
    if (iskv) {
      float* cd = nullptr;
      if (tok < TP) { if (tok >= TP - R) cd = cache_p + (size_t)(tok - (TP - R)) * dstw + col; }
      else { const int s = tok - TP; cd = cache_s + ((size_t)(s >> 6) * R + (R - 64) + (s & 63)) * dstw + col; }
      if (cd) {
#pragma unroll
        for (int q = 0; q < 4; ++q) *(float4*)(cd + q * 4) = make_float4(v[q * 4], v[q * 4 + 1], v[q * 4 + 2], v[q * 4 + 3]);
      }
    }
  }
  if (kind == 2) {
    const int ROWS = isB ? KB_ROWS : KA_ROWS;
#pragma unroll 1
    for (int i = 0; i < 8; ++i) {
      const int item = tid + NT * i; const int g8 = item & 15, c = item >> 4;
      float v[8];
#pragma unroll
      for (int q = 0; q < 8; ++q) v[q] = Ct[(g8 * 8 + q) * CTS + c];
      const int tok = row0 + g8 * 8;
      const int kr = isB ? krowB(tok) : krowA(tok);
      *(uint4*)(dst + (size_t)(cb + c) * ROWS + kr) = make_uint4(pack2(v[0], v[1]), pack2(v[2], v[3]), pack2(v[4], v[5]), pack2(v[6], v[7]));
    }
  }
  __syncthreads();
}

template <int NG, bool ISB>
DI void attn_item(const Params& p, int l, int sc, int h) {
  const int lane = tidx() & 63, wid = tidx() >> 6, fr = lane & 15, fq = lane >> 4;
  constexpr int KW = ISB ? 512 : 128;
  constexpr int KROWS = ISB ? KB_ROWS : KA_ROWS;
  constexpr int R = ISB ? 512 : 128;
  u16* Q = (u16*)(p.ws + (ISB ? OFF_QB : OFF_QA));
  const u16* Kp = (const u16*)(p.ws + (ISB ? OFF_KB : OFF_KA));
  const u16* Vt = (const u16*)(p.ws + (ISB ? OFF_VTB : OFF_VTA));
  int tokq0, kband0, firstblk;
  if (sc < 256) { tokq0 = sc * 64; kband0 = sc * 64 - R; firstblk = kband0 < 0 ? ((-kband0) >> 4) : 0; }
  else { const int b = sc - 256; tokq0 = TP + b * 64; kband0 = TP + b * (R + 64); firstblk = 0; }
  const int hk = ISB ? h : (h >> 2);
  const int qrow = tokq0 + wid * 16 + fr;
  bf16x8 qf[2];
#pragma unroll
  for (int kk = 0; kk < 2; ++kk) qf[kk] = *(const bf16x8*)(Q + (size_t)qrow * 512 + h * 64 + kk * 32 + fq * 8);
  const float* table = p.in[11] + (size_t)(l * 8 + h) * 257;
  float tconst = 0.f;
  if (ISB) tconst = table[256];
  const int qi = wid * 16 + fr;
  float m_run, l_run;
  if (ISB) { m_run = -1e30f; l_run = 0.f; } else { m_run = p.in[10][l * 8 + h]; l_run = 1.f; }
  f32x4 o[4];
#pragma unroll
  for (int d = 0; d < 4; ++d) o[d] = f32x4{0.f, 0.f, 0.f, 0.f};
#pragma unroll 1
  for (int g = 0; g < NG; ++g) {
    const int fb = firstblk - g * 12;
    if (fb >= 12) continue;
    const int kb0 = kband0 + g * 192;
    f32x4 s[12];
#pragma unroll
    for (int blk = 0; blk < 12; ++blk) {
      f32x4 a = {0.f, 0.f, 0.f, 0.f};
      if (blk >= fb) {
        const u16* kr = Kp + (size_t)(kb0 + blk * 16 + fr) * KW + hk * 64 + fq * 8;
        const bf16x8 k0 = *(const bf16x8*)kr, k1 = *(const bf16x8*)(kr + 32);
        a = MFMA16(k0, qf[0], a); a = MFMA16(k1, qf[1], a);
      }
      s[blk] = a;
    }
    float mx = -1e30f;
#pragma unroll
    for (int blk = 0; blk < 12; ++blk) {
#pragma unroll
      for (int j = 0; j < 4; ++j) {
        float v = s[blk][j] * 0.125f;
        if (ISB) {
          if (g < 2) v += tconst;
          else { int rel = 128 + qi - (blk * 16 + fq * 4 + j); rel = rel < -128 ? -128 : rel; v += table[rel + 128]; }
        }
        if (blk < fb) v = -1e30f;
        s[blk][j] = v; mx = fmaxf(mx, v);
      }
    }
    mx = fmaxf(mx, __shfl_xor(mx, 16, 64)); mx = fmaxf(mx, __shfl_xor(mx, 32, 64));
    const float m_new = fmaxf(m_run, mx);
    const float scale = __expf(m_run - m_new);
    m_run = m_new;
    float sum = 0.f;
#pragma unroll
    for (int blk = 0; blk < 12; ++blk)
#pragma unroll
      for (int j = 0; j < 4; ++j) { const float e = __expf(s[blk][j] - m_new); s[blk][j] = e; sum += e; }
    sum += __shfl_xor(sum, 16, 64); sum += __shfl_xor(sum, 32, 64);
    l_run = l_run * scale + sum;
#pragma unroll
    for (int d = 0; d < 4; ++d) { o[d][0] *= scale; o[d][1] *= scale; o[d][2] *= scale; o[d][3] *= scale; }
#pragma unroll
    for (int pp = 0; pp < 6; ++pp) {
      if (2 * pp >= fb) {
        uint4 pk = make_uint4(pack2(s[2 * pp][0], s[2 * pp][1]), pack2(s[2 * pp][2], s[2 * pp][3]),
                              pack2(s[2 * pp + 1][0], s[2 * pp + 1][1]), pack2(s[2 * pp + 1][2], s[2 * pp + 1][3]));
        const bf16x8 pb = __builtin_bit_cast(bf16x8, pk);
#pragma unroll
        for (int d = 0; d < 4; ++d) {
          const u16* vr = Vt + (size_t)(hk * 64 + d * 16 + fr) * KROWS + kb0 + pp * 32 + fq * 4;
          const uint2 lo = *(const uint2*)vr, hi = *(const uint2*)(vr + 16);
          const bf16x8 va = __builtin_bit_cast(bf16x8, make_uint4(lo.x, lo.y, hi.x, hi.y));
          o[d] = MFMA16(va, pb, o[d]);
        }
      }
    }
  }
  const float inv = 1.f / l_run;
#pragma unroll
  for (int d = 0; d < 4; ++d)
    *(uint2*)(Q + (size_t)qrow * 512 + h * 64 + d * 16 + fq * 4) = make_uint2(pack2(o[d][0] * inv, o[d][1] * inv), pack2(o[d][2] * inv, o[d][3] * inv));
}

constexpr int HS = 20;
template <bool OUT>
DI void hgrn_item(const Params& p, int l, int cidx, int h, char* smem) {
  const int tid = tidx(), v = tid & 127, half = tid >> 7;
  unsigned char* ws = p.ws;
  float* qdT = (float*)smem;
  float* kdT = qdT + 128 * HS;
  float* kpT = kdT + 128 * HS;
  float* vS = kpT + 128 * HS;
  float* ob0 = vS + 2048;
  float* AsT = ob0 + 4096;
  float* tot = AsT + 256;
  float* dec = tot + 256;
  const u16* Hf = (const u16*)(ws + OFF_HF); const u16* Hi = (const u16*)(ws + OFF_HI);
  u16* Hq = (u16*)(ws + OFF_HQ); const u16* Hog = (const u16*)(ws + OFF_HOG);
  const bool sample = OUT && cidx >= 128;
  const int tok_base = sample ? TP + (cidx - 128) * 64 : cidx * 128;
  const int nsb = sample ? 4 : 8;
  float lb = 0.f;
  { const int k = tid & 127; if (l == 1) lb = sigmoidf_(p.in[12][512 + h * 128 + k] - p.in[12][h * 128 + k]); }
  float S[64];
  if (OUT) {
    const float* s0 = sample ? p.in[6] + ((size_t)(l * 8 + (cidx - 128)) * 4 + h) * 16384
                             : (const float*)(ws + OFF_ST) + ((size_t)cidx * 4 + h) * 16384;
    const float* ps = s0 + (size_t)(half * 64) * 128 + v;
#pragma unroll
    for (int kk = 0; kk < 64; ++kk) {
      if ((kk & 7) == 0) asm volatile("" : "+v"(ps));
      S[kk] = ps[(kk & 7) * 128];
      if ((kk & 7) == 7) ps += 8 * 128;
    }
  } else {
#pragma unroll
    for (int kk = 0; kk < 64; ++kk) S[kk] = 0.f;
  }
  float lastsum = 0.f;
#pragma unroll 1
  for (int sb = 0; sb < nsb; ++sb) {
    const int tok0 = tok_base + sb * 16;
    __syncthreads();
    float lf[8], kk8[8], q8[8];
    {
      const int k = v;
      float run = 0.f;
#pragma unroll
      for (int i = 0; i < 8; ++i) {
        const size_t off = (size_t)(tok0 + half * 8 + i) * 512 + h * 128 + k;
        const float z = bf2f(Hf[off]);
        const float e = __expf(-fabsf(z));
        const float sp = 1.f / (1.f + e);
        const float sig = z >= 0.f ? sp : e * sp;
        const float nsig = z >= 0.f ? e * sp : sp;
        float lfi;
        if (lb > 0.f) lfi = __logf(lb + (1.f - lb) * sig);
        else lfi = fminf(z, 0.f) - log1pf(e);
        run += lfi; lf[i] = run;
        kk8[i] = (1.f - lb) * nsig;
        if (OUT) { const float qp = bf2f(Hq[off]); q8[i] = qp * sigmoidf_(qp); } else q8[i] = 0.f;
        vS[(half * 8 + i) * 128 + k] = bf2f(Hi[off]);
      }
      tot[half * 128 + k] = run;
    }
    __syncthreads();
    {
      const int k = v;
      const float t0 = tot[k], t1 = tot[128 + k];
      const float last = t0 + t1, base = half ? t0 : 0.f;
      float qd[8], kd[8], kp[8];
#pragma unroll
      for (int i = 0; i < 8; ++i) {
        const float cum = base + lf[i];
        qd[i] = q8[i] * __expf(cum);
        kd[i] = kk8[i] * __expf(last - cum);
        kp[i] = kk8[i] * __expf(fminf(-cum, 80.f));
      }
      float* d0 = kdT + k * HS + half * 8;
      *(float4*)d0 = make_float4(kd[0], kd[1], kd[2], kd[3]); *(float4*)(d0 + 4) = make_float4(kd[4], kd[5], kd[6], kd[7]);
      if (OUT) {
        float* d1 = qdT + k * HS + half * 8; float* d2 = kpT + k * HS + half * 8;
        *(float4*)d1 = make_float4(qd[0], qd[1], qd[2], qd[3]); *(float4*)(d1 + 4) = make_float4(qd[4], qd[5], qd[6], qd[7]);
        *(float4*)d2 = make_float4(kp[0], kp[1], kp[2], kp[3]); *(float4*)(d2 + 4) = make_float4(kp[4], kp[5], kp[6], kp[7]);
      }
      if (half == 0) dec[k] = __expf(last);
      lastsum += last;
    }
    __syncthreads();
    float vreg[16];
#pragma unroll
    for (int t = 0; t < 16; ++t) vreg[t] = vS[t * 128 + v];
    if (OUT) {
#ifndef HX3
      {
        const int t = tid >> 4, s = tid & 15;
        float a = 0.f;
#pragma unroll 8
        for (int k = 0; k < 128; ++k) a += qdT[k * HS + t] * kpT[k * HS + s];
        AsT[s * 16 + t] = (s <= t) ? a : 0.f;
      }
#endif
      float o[16];
#pragma unroll
      for (int t = 0; t < 16; ++t) o[t] = 0.f;
#ifndef HX4
#pragma unroll
      for (int kk = 0; kk < 64; ++kk) {
        asm volatile("" ::: "memory");
        const float* qr = qdT + (half * 64 + kk) * HS;
        const float sv = S[kk];
#pragma unroll
        for (int q = 0; q < 4; ++q) { const float4 t4 = *(const float4*)(qr + q * 4); o[q * 4] += sv * t4.x; o[q * 4 + 1] += sv * t4.y; o[q * 4 + 2] += sv * t4.z; o[q * 4 + 3] += sv * t4.w; }
      }
#endif
      __syncthreads();
#pragma unroll
      for (int si = 0; si < 8; ++si) {
        const int s = half * 8 + si;
        const float vs = vreg[s];
        const float* ar = AsT + s * 16;
#pragma unroll
        for (int q = 0; q < 4; ++q) { const float4 t4 = *(const float4*)(ar + q * 4); o[q * 4] += vs * t4.x; o[q * 4 + 1] += vs * t4.y; o[q * 4 + 2] += vs * t4.z; o[q * 4 + 3] += vs * t4.w; }
      }
      float* ob = ob0 + half * 2048;
#pragma unroll
      for (int t = 0; t < 16; ++t) ob[t * 128 + v] = o[t];
      __syncthreads();
#ifndef HX6
      {
        const int t = tid >> 4, seg = tid & 15;
        float ov[8];
        const float4 a0 = *(const float4*)(ob0 + t * 128 + seg * 8), a1 = *(const float4*)(ob0 + t * 128 + seg * 8 + 4);
        const float4 b0 = *(const float4*)(ob0 + 2048 + t * 128 + seg * 8), b1 = *(const float4*)(ob0 + 2048 + t * 128 + seg * 8 + 4);
        ov[0] = a0.x + b0.x; ov[1] = a0.y + b0.y; ov[2] = a0.z + b0.z; ov[3] = a0.w + b0.w;
        ov[4] = a1.x + b1.x; ov[5] = a1.y + b1.y; ov[6] = a1.z + b1.z; ov[7] = a1.w + b1.w;
        float ss = 0.f;
#pragma unroll
        for (int q = 0; q < 8; ++q) ss += ov[q] * ov[q];
        ss += __shfl_xor(ss, 1, 64); ss += __shfl_xor(ss, 2, 64); ss += __shfl_xor(ss, 4, 64); ss += __shfl_xor(ss, 8, 64);
        const float rn = rsqrtf(ss * (1.f / 128.f) + EPS);
        const size_t off = (size_t)(tok0 + t) * 512 + h * 128 + seg * 8;
        const uint4 ogp = *(const uint4*)(Hog + off);
        const unsigned ogw[4] = {ogp.x, ogp.y, ogp.z, ogp.w};
        const float* cn = p.in[13] + l * 512 + h * 128 + seg * 8;
        float r8[8];
#pragma unroll
        for (int q = 0; q < 8; ++q) {
          const float g = (q & 1) ? hi_f(ogw[q >> 1]) : lo_f(ogw[q >> 1]);
          r8[q] = ov[q] * rn * cn[q] * (g * sigmoidf_(g));
        }
        *(uint4*)(Hq + off) = make_uint4(pack2(r8[0], r8[1]), pack2(r8[2], r8[3]), pack2(r8[4], r8[5]), pack2(r8[6], r8[7]));
      }
#endif
    }
#ifndef HX7
#pragma unroll
    for (int kk = 0; kk < 64; ++kk) {
      asm volatile("" ::: "memory");
      const int k = half * 64 + kk;
      const float* kr = kdT + k * HS;
      float a = dec[k] * S[kk];
#pragma unroll
      for (int q = 0; q < 4; ++q) { const float4 t4 = *(const float4*)(kr + q * 4); a += t4.x * vreg[q * 4] + t4.y * vreg[q * 4 + 1] + t4.z * vreg[q * 4 + 2] + t4.w * vreg[q * 4 + 3]; }
      S[kk] = a;
    }
#endif
  }
  if (!OUT) {
    float* D = (float*)(ws + OFF_ST) + ((size_t)cidx * 4 + h) * 16384 + (size_t)(half * 64) * 128 + v;
#pragma unroll
    for (int kk = 0; kk < 64; ++kk) {
      if ((kk & 7) == 0) asm volatile("" : "+v"(D));
      D[(kk & 7) * 128] = S[kk];
      if ((kk & 7) == 7) D += 8 * 128;
    }
    if (half == 0) ((float*)(ws + OFF_DECAY))[((size_t)cidx * 4 + h) * 128 + v] = __expf(lastsum);
  } else if (sample) {
    float* D = p.out + O_CS + ((size_t)(l * 8 + (cidx - 128)) * 4 + h) * 16384 + (size_t)(half * 64) * 128 + v;
#pragma unroll
    for (int kk = 0; kk < 64; ++kk) {
      if ((kk & 7) == 0) asm volatile("" : "+v"(D));
      D[(kk & 7) * 128] = S[kk];
      if ((kk & 7) == 7) D += 8 * 128;
    }
  }
  __syncthreads();
}

DI void hgrn_scan(const Params& p, int l) {
  float* ST = (float*)(p.ws + OFF_ST); const float* DEC = (const float*)(p.ws + OFF_DECAY);
  for (int e = blockIdx.x * NT + tidx(); e < 65536; e += gridDim.x * NT) {
    const int h = e >> 14, k = (e >> 7) & 127;
    float S = 0.f;
    float* ptr = ST + (size_t)h * 16384 + (e & 16383);
    const float* dp = DEC + h * 128 + k;
#pragma unroll 1
    for (int c0 = 0; c0 < 128; c0 += 8) {
      float d[8], dc[8];
#pragma unroll
      for (int i = 0; i < 8; ++i) { d[i] = ptr[(size_t)(c0 + i) * 65536]; dc[i] = dp[(c0 + i) * 512]; }
#pragma unroll
      for (int i = 0; i < 8; ++i) { ptr[(size_t)(c0 + i) * 65536] = S; S = dc[i] * S + d[i]; }
    }
    p.out[O_CP + (size_t)l * 65536 + e] = S;
  }
}

DI void p5_tile(const Params& p, int l, int rt, int ct, char* smem) {
  const int tid = tidx(), lane = tid & 63, wid = tid >> 6, wr = wid >> 1, fq = lane >> 4;
  unsigned char* ws = p.ws;
  float* Ct = (float*)smem; float* rs = (float*)(smem + 73728);
  const float* rowsq1 = (const float*)(ws + OFF_ROWSQ1);
  const int row0 = rt * 128, c0 = ct * 64;
  __syncthreads();
  if (tid < 128) rs[tid] = rsqrtf(rowsq1[row0 + tid] * (1.f / 1024.f) + EPS);
  f32x4 mix[4][2];
#pragma unroll
  for (int m = 0; m < 4; ++m)
#pragma unroll
    for (int n = 0; n < 2; ++n) mix[m][n] = f32x4{0.f, 0.f, 0.f, 0.f};
#pragma unroll 1
  for (int br = 0; br < 3; ++br) {
    f32x4 acc[4][2];
    gemm_tile<2>(acc, (const u16*)(ws + OFF_XB), 1024, row0, 0, T, (const u16*)(ws + OFF_WIN) + (size_t)(NIN1 + br * 1024 + c0) * 1024, 1024, 1024, smem);
    uint2 sg[4][2];
#pragma unroll
    for (int m = 0; m < 4; ++m) {
      const float4 r4 = *(const float4*)(rs + wr * 64 + m * 16 + fq * 4);
#pragma unroll
      for (int n = 0; n < 2; ++n)
        sg[m][n] = make_uint2(pack2(sigmoidf_(acc[m][n][0] * r4.x), sigmoidf_(acc[m][n][1] * r4.y)),
                              pack2(sigmoidf_(acc[m][n][2] * r4.z), sigmoidf_(acc[m][n][3] * r4.w)));
    }
    const u16* Ob = (const u16*)(ws + (br == 0 ? OFF_QA : (br == 1 ? OFF_QB : OFF_HQ)));
    gemm_tile<2>(acc, Ob, 512, row0, 0, T, (const u16*)(ws + OFF_WA + br * W_BR_B) + (size_t)c0 * 512, 512, 512, smem);
#pragma unroll
    for (int m = 0; m < 4; ++m)
#pragma unroll
      for (int n = 0; n < 2; ++n)
      {
        mix[m][n][0] += lo_f(sg[m][n].x) * acc[m][n][0]; mix[m][n][1] += hi_f(sg[m][n].x) * acc[m][n][1];
        mix[m][n][2] += lo_f(sg[m][n].y) * acc[m][n][2]; mix[m][n][3] += hi_f(sg[m][n].y) * acc[m][n][3];
      }
  }
  acc_to_lds<2>(mix, Ct, nullptr);
  u16* mixb = (u16*)(ws + OFF_MIX);
#pragma unroll 1
  for (int i = 0; i < 2; ++i) {
    const int item = tid + NT * i; const int r = item >> 2, g = item & 3;
    float v[16];
#pragma unroll
    for (int q = 0; q < 4; ++q) { const float4 t4 = *(const float4*)(Ct + r * CTS + g * 16 + q * 4); v[q * 4] = t4.x; v[q * 4 + 1] = t4.y; v[q * 4 + 2] = t4.z; v[q * 4 + 3] = t4.w; }
    u16* d = mixb + (size_t)(row0 + r) * 1024 + c0 + g * 16;
    *(uint4*)d = make_uint4(pack2(v[0], v[1]), pack2(v[2], v[3]), pack2(v[4], v[5]), pack2(v[6], v[7]));
    *(uint4*)(d + 8) = make_uint4(pack2(v[8], v[9]), pack2(v[10], v[11]), pack2(v[12], v[13]), pack2(v[14], v[15]));
  }
  __syncthreads();
}

DI void resid_tile(const Params& p, const u16* A, int lda, const u16* W, int K, float* rowsq, int rt, int ct, char* smem) {
  const int tid = tidx();
  float* Ct = (float*)smem;
  const int row0 = rt * 128, c0 = ct * 128;
  f32x4 acc[4][4];
  gemm_tile<4>(acc, A, lda, row0, 0, T, W + (size_t)c0 * K, K, K, smem);
  acc_to_lds<4>(acc, Ct, nullptr);
  float* x = p.out; u16* xb = (u16*)(p.ws + OFF_XB);
#pragma unroll 1
  for (int i = 0; i < 4; ++i) {
    const int item = tid + NT * i; const int r = item >> 3, g = item & 7;
    float* xp = x + (size_t)(row0 + r) * 1024 + c0 + g * 16;
    float v[16]; float ss = 0.f;
#pragma unroll
    for (int q = 0; q < 4; ++q) {
      const float4 t4 = *(const float4*)(Ct + r * CTS + g * 16 + q * 4); float4 x4 = *(const float4*)(xp + q * 4);
      x4.x += t4.x; x4.y += t4.y; x4.z += t4.z; x4.w += t4.w;
      *(float4*)(xp + q * 4) = x4;
      v[q * 4] = x4.x; v[q * 4 + 1] = x4.y; v[q * 4 + 2] = x4.z; v[q * 4 + 3] = x4.w;
      ss += x4.x * x4.x + x4.y * x4.y + x4.z * x4.z + x4.w * x4.w;
    }
    u16* d = xb + (size_t)(row0 + r) * 1024 + c0 + g * 16;
    *(uint4*)d = make_uint4(pack2(v[0], v[1]), pack2(v[2], v[3]), pack2(v[4], v[5]), pack2(v[6], v[7]));
    *(uint4*)(d + 8) = make_uint4(pack2(v[8], v[9]), pack2(v[10], v[11]), pack2(v[12], v[13]), pack2(v[14], v[15]));
    ss += __shfl_xor(ss, 1, 64); ss += __shfl_xor(ss, 2, 64); ss += __shfl_xor(ss, 4, 64);
    if (g == 0) atomicAdd(rowsq + row0 + r, ss);
  }
  __syncthreads();
}

DI float gelu_tanh(float g) { const float u = 0.7978845608028654f * (g + 0.044715f * g * g * g); return 0.5f * g * (1.f + tanhf(u)); }
DI void p7_tile(const Params& p, int l, int rt, int ct, char* smem) {
  const int tid = tidx();
  unsigned char* ws = p.ws;
  float* Ct = (float*)smem; float* rs = (float*)(smem + 73728);
  const float* rowsq2 = (const float*)(ws + OFF_ROWSQ2);
  const bool sample = rt >= 131;
  const int base = sample ? TP + (rt - 131) * 128 : rt * 126 - 2;
  const int lo = sample ? TP : 0, hi = sample ? T : TP;
  __syncthreads();
  if (tid < 128) { const int g = base + tid; rs[tid] = (g >= lo && g < hi) ? rsqrtf(rowsq2[g] * (1.f / 1024.f) + EPS) : 0.f; }
  f32x4 acc[4][4];
  gemm_tile<4>(acc, (const u16*)(ws + OFF_XB), 1024, base, lo, hi, (const u16*)(ws + OFF_WUP) + (size_t)ct * 128 * 1024, 1024, 1024, smem);
  acc_to_lds<4>(acc, Ct, rs);
  const float* wconv = p.in[20] + (size_t)l * 3 * DFF2; const float* bconv = p.in[21] + (size_t)l * DFF2;
  const float* cstate = p.in[7] + (size_t)l * 8 * 2 * DFF2;
  u16* act = (u16*)(ws + OFF_ACT);
#pragma unroll 1
  for (int i = 0; i < 16; ++i) {
    const int item = tid + NT * i; const int r = item >> 5, jp = item & 31;
    const int tok = base + r;
    bool valid; int bi = 0, ti = 2;
    if (sample) { valid = true; bi = (tok - TP) >> 6; ti = (tok - TP) & 63; }
    else valid = (r >= 2) && (tok < TP);
    if (!valid) continue;
    float cv[4];
#pragma unroll
    for (int q = 0; q < 2; ++q) {
#pragma unroll
      for (int ug = 0; ug < 2; ++ug) {
        const int jc = jp * 2 + q;
        const int lc = jc + ug * 64;
        const int oc = ug * DFF + ct * 64 + jc;
        const float u2 = Ct[r * CTS + lc];
        const float u1 = (ti >= 1) ? Ct[(r - 1) * CTS + lc] : cstate[((size_t)bi * 2 + 1) * DFF2 + oc];
        const float u0 = (ti >= 2) ? Ct[(r - 2) * CTS + lc] : cstate[((size_t)bi * 2 + ti) * DFF2 + oc];
        cv[q * 2 + ug] = bconv[oc] + wconv[oc] * u0 + wconv[DFF2 + oc] * u1 + wconv[2 * DFF2 + oc] * u2;
        if (!sample) { if (tok >= TP - 2) p.out[O_CVP + ((size_t)l * 2 + (tok - (TP - 2))) * DFF2 + oc] = u2; }
        else if (ti >= 62) p.out[O_CVS + (((size_t)l * 8 + bi) * 2 + (ti - 62)) * DFF2 + oc] = u2;
      }
    }
    *(unsigned*)(act + (size_t)tok * DFF + ct * 64 + jp * 2) = pack2(cv[0] * gelu_tanh(cv[1]), cv[2] * gelu_tanh(cv[3]));
  }
  __syncthreads();
}

DI void final_norm(const Params& p) {
  const int lane = tidx() & 63, wid = tidx() >> 6;
  const float* rowsq1 = (const float*)(p.ws + OFF_ROWSQ1);
  for (int it = blockIdx.x; it < T / 4; it += gridDim.x) {
    const int row = it * 4 + wid;
    const float rstd = rsqrtf(rowsq1[row] * (1.f / 1024.f) + EPS);
#pragma unroll
    for (int i = 0; i < 4; ++i) {
      const int c = (i * 64 + lane) * 4;
      float4 v = *(float4*)(p.out + (size_t)row * 1024 + c);
      const float4 g = *(const float4*)(p.in[23] + c);
      v.x *= rstd * g.x; v.y *= rstd * g.y; v.z *= rstd * g.z; v.w *= rstd * g.w;
      *(float4*)(p.out + (size_t)row * 1024 + c) = v;
    }
  }
}

__global__ void __launch_bounds__(NT, 2) fwd_megakernel(Params p) {
  extern __shared__ __attribute__((aligned(16))) char smem[];
  cg::grid_group grid = cg::this_grid();
#if USE_CG_SYNC
#define GSYNC() grid.sync()
#else
  __shared__ uint4 xb_words;
  if (threadIdx.x == 0) xb_words = make_uint4(0u, 0u, 0u, 0u);
  __syncthreads();
  XcdBarrier xb = xcd_barrier_post((unsigned*)(p.ws + OFF_BAR), (volatile LAS unsigned*)&xb_words);
  grid.sync();
#define GSYNC() xcd_barrier(xb)
#endif
  const int G = gridDim.x, bid = blockIdx.x;
  unsigned char* ws = p.ws;
  if (PHM & 1) phase0(p, smem);
  GSYNC();
  for (int l = 0; l < 2; ++l) {
    if (PHM & 2) cache_to_kv(p, l);
    if (PHM & 2) for (int it = bid; it < 132 * 34; it += G) p1_tile(p, l, it % 132, it / 132, smem);
    { float* rq2 = (float*)(ws + OFF_ROWSQ2); for (int i = bid * NT + threadIdx.x; i < T; i += G * NT) rq2[i] = 0.f; }
    GSYNC();
    for (int it = bid; it < 264 * 8 + 512 + 264 * 8; it += G) {
      if (it < 2112) { if (PHM & 4) attn_item<3, true>(p, l, it >> 3, it & 7); }
      else if (it < 2624) { const int j = it - 2112; if (PHM & 8) hgrn_item<false>(p, l, j >> 2, j & 3, smem); }
      else { const int j = it - 2624; if (PHM & 16) attn_item<1, false>(p, l, j >> 3, j & 7); }
    }
    GSYNC();
    if (PHM & 32) hgrn_scan(p, l);
    GSYNC();
    if (PHM & 64) for (int it = bid; it < 136 * 4; it += G) hgrn_item<true>(p, l, it >> 2, it & 3, smem);
    GSYNC();
    if (PHM & 128) for (int it = bid; it < NCONV_FFN; it += G) conv_wffn_item(p, l, it, smem);
    if (PHM & 256) for (int it = bid; it < 132 * 16; it += G) p5_tile(p, l, it % 132, it / 132, smem);
    GSYNC();
    { float* rq1 = (float*)(ws + OFF_ROWSQ1); for (int i = bid * NT + threadIdx.x; i < T; i += G * NT) rq1[i] = 0.f; }
    if (PHM & 512) for (int it = bid; it < 132 * 8; it += G)
      resid_tile(p, (const u16*)(ws + OFF_MIX), 1024, (const u16*)(ws + OFF_WOUT), 1024, (float*)(ws + OFF_ROWSQ2), it % 132, it / 132, smem);
    GSYNC();
    if (PHM & 1024) for (int it = bid; it < 135 * 44; it += G) p7_tile(p, l, it % 135, it / 135, smem);
    GSYNC();
    if (l == 0) for (int it = bid; it < NCONV_MIX; it += G) conv_wmix_item(p, 1, it, smem);
    if (PHM & 2048) for (int it = bid; it < 132 * 8; it += G)
      resid_tile(p, (const u16*)(ws + OFF_ACT), DFF, (const u16*)(ws + OFF_WDOWN), DFF, (float*)(ws + OFF_ROWSQ1), it % 132, it / 132, smem);
    GSYNC();
  }
  final_norm(p);
}

extern "C" void kernel_launch(void* const* d_in, const int* in_sizes, int n_in, void* d_out, int out_size,
                              void* d_ws, size_t ws_size, hipStream_t stream) {
  static int grid_blocks = 0;
  if (!grid_blocks) {
    int dev = 0, cus = 0, per_cu = 0;
    hipGetDevice(&dev);
    hipDeviceGetAttribute(&cus, hipDeviceAttributeMultiprocessorCount, dev);
    hipFuncSetAttribute((const void*)fwd_megakernel, hipFuncAttributeMaxDynamicSharedMemorySize, LDS_BYTES);
    hipOccupancyMaxActiveBlocksPerMultiprocessor(&per_cu, (const void*)fwd_megakernel, NT, LDS_BYTES);
    if (per_cu < 1) per_cu = 1;
    if (per_cu > 2) per_cu = 2;
    grid_blocks = cus * per_cu;
    if (ws_size < WS_END || (size_t)out_size < O_END || n_in < 24)
      fprintf(stderr, "kernel_launch: unexpected sizes ws=%zu need=%zu out=%d need=%zu n_in=%d\n", ws_size, (size_t)WS_END, out_size, (size_t)O_END, n_in);
  }
  Params p{};
  for (int i = 0; i < 24; ++i) p.in[i] = (const float*)d_in[i];
  p.out = (float*)d_out; p.ws = (unsigned char*)d_ws;
  hipMemsetAsync((char*)d_ws + OFF_BAR, 0, 16384, stream);
  void* args[] = {&p};
  hipError_t e = hipLaunchCooperativeKernel((const void*)fwd_megakernel, dim3(grid_blocks), dim3(NT), args, LDS_BYTES, stream);
  if (e != hipSuccess) fprintf(stderr, "cooperative launch failed: %s (grid %d)\n", hipGetErrorString(e), grid_blocks);
}
```

```cpp
#include <hip/hip_runtime.h>
#include <hip/hip_cooperative_groups.h>
#include <cstdio>
namespace cg = cooperative_groups;

typedef unsigned short u16;
using bf16x8 = __attribute__((ext_vector_type(8))) short;
using f32x4 = __attribute__((ext_vector_type(4))) float;
#define DI __device__ __forceinline__
#define MFMA16(a, b, c) __builtin_amdgcn_mfma_f32_16x16x32_bf16((a), (b), (c), 0, 0, 0)

#ifndef PHM
#define PHM 0xFFFF
#endif
#ifndef USE_CG_SYNC
#define USE_CG_SYNC 0
#endif

constexpr int DM = 1024, TP = 16384, TS = 512, T = TP + TS, NBATCH = 8;
constexpr int INW = 7424, NIN1 = 4352;
constexpr int DFF = 2816, DFF2 = 5632;
constexpr int KA_ROWS = TP + NBATCH * 192, KB_ROWS = TP + NBATCH * 576;
constexpr int NT = 256;
constexpr float EPS = 1e-6f;
constexpr int LDS_BYTES = 73728 + 1024;

constexpr size_t OFF_BAR   = 0;
constexpr size_t OFF_ROWSQ1 = 16384;
constexpr size_t OFF_ROWSQ2 = OFF_ROWSQ1 + 67584;
constexpr size_t OFF_DECAY = OFF_ROWSQ2 + 67584;
constexpr size_t OFF_WMIX  = OFF_DECAY + 262144;
constexpr size_t W_IN_B = (size_t)INW * 1024 * 2, W_BR_B = (size_t)1024 * 512 * 2, W_OUT_B = (size_t)1024 * 1024 * 2;
constexpr size_t OFF_WIN = OFF_WMIX, OFF_WA = OFF_WIN + W_IN_B, OFF_WB = OFF_WA + W_BR_B, OFF_WC = OFF_WB + W_BR_B, OFF_WOUT = OFF_WC + W_BR_B;
constexpr size_t OFF_XB    = OFF_WOUT + W_OUT_B;
constexpr size_t OFF_ST    = OFF_XB + (size_t)T * 1024 * 2;
constexpr size_t OFF_WUP = OFF_ST, OFF_WDOWN = OFF_ST + (size_t)DFF2 * 1024 * 2;
constexpr size_t OFF_QA    = OFF_ST + (size_t)128 * 4 * 16384 * 4;
constexpr size_t PLANE = (size_t)T * 512 * 2;
constexpr size_t OFF_QB    = OFF_QA + PLANE;
constexpr size_t OFF_KA    = OFF_QB + PLANE;
constexpr size_t OFF_VTA   = OFF_KA + (size_t)KA_ROWS * 128 * 2;
constexpr size_t OFF_KB    = OFF_VTA + (size_t)KA_ROWS * 128 * 2;
constexpr size_t OFF_VTB   = OFF_KB + (size_t)KB_ROWS * 512 * 2;
constexpr size_t OFF_HF    = OFF_VTB + (size_t)KB_ROWS * 512 * 2;
constexpr size_t OFF_HI = OFF_HF + PLANE, OFF_HQ = OFF_HI + PLANE, OFF_HOG = OFF_HQ + PLANE;
constexpr size_t WS_END = OFF_HOG + PLANE;
constexpr size_t OFF_MIX = OFF_HF;
constexpr size_t OFF_ACT = OFF_QA;
static_assert(OFF_ACT + (size_t)T * DFF * 2 <= WS_END, "act fits");

constexpr size_t O_X = 0;
constexpr size_t O_AKP = (size_t)T * 1024;
constexpr size_t O_AVP = O_AKP + 32768;
constexpr size_t O_BKP = O_AVP + 32768;
constexpr size_t O_BVP = O_BKP + 524288;
constexpr size_t O_CP  = O_BVP + 524288;
constexpr size_t O_CVP = O_CP + 131072;
constexpr size_t O_AKS = O_CVP + 22528;
constexpr size_t O_AVS = O_AKS + 262144;
constexpr size_t O_BKS = O_AVS + 262144;
constexpr size_t O_BVS = O_BKS + 4194304;
constexpr size_t O_CS  = O_BVS + 4194304;
constexpr size_t O_CVS = O_CS + 1048576;
constexpr size_t O_END = O_CVS + 180224;

struct Params { const float* in[24]; float* out; unsigned char* ws; };

DI u16 f2bf(float x) { unsigned u = __float_as_uint(x); u += 0x7fffu + ((u >> 16) & 1u); return (u16)(u >> 16); }
DI float bf2f(u16 v) { return __uint_as_float(((unsigned)v) << 16); }
DI unsigned pack2(float a, float b) { return (unsigned)f2bf(a) | ((unsigned)f2bf(b) << 16); }
DI float lo_f(unsigned u) { return __uint_as_float(u << 16); }
DI float hi_f(unsigned u) { return __uint_as_float(u & 0xffff0000u); }
DI float wave_sum(float v) {
#pragma unroll
  for (int o = 32; o >= 1; o >>= 1) v += __shfl_xor(v, o, 64);
  return v;
}
DI int tidx() { int t = threadIdx.x; asm volatile("" : "+v"(t)); return t; }
DI float sigmoidf_(float x) { return 1.f / (1.f + __expf(-x)); }
DI int krowA(int tok) { if (tok < TP) return tok; int s = tok - TP; return TP + (s >> 6) * 192 + 128 + (s & 63); }
DI int krowB(int tok) { if (tok < TP) return tok; int s = tok - TP; return TP + (s >> 6) * 576 + 512 + (s & 63); }

#define XB_TMO      128
#define XB_XCNT(j)  (256  + 64 * (j))
#define XB_XSUB(j)  (1280 + 64 * (j))
#define XB_XGEN(j)  (2304 + 64 * (j))
#define XB_TOP      3328
#define XB_TOPGEN   3392
#define XCD_BAR_WORDS 3456
#define XB_SPIN_CAP (1u << 24)
#define LAS __attribute__((address_space(3)))
DI unsigned xb_ld(unsigned* p) { return __hip_atomic_load(p, __ATOMIC_RELAXED, __HIP_MEMORY_SCOPE_AGENT); }
DI unsigned xb_add(unsigned* p, unsigned v) { return __hip_atomic_fetch_add(p, v, __ATOMIC_RELAXED, __HIP_MEMORY_SCOPE_AGENT); }
DI unsigned xb_xcc_id() { return (unsigned)__builtin_amdgcn_s_getreg((3 << 11) | 20) & 0xFu; }
#define XB_SPIN(cond, bar) do { unsigned _sp = 0; while (cond) { __builtin_amdgcn_s_sleep(1); \
    if ((++_sp & 255u) == 0u) { if (xb_ld(&(bar)[XB_TMO])) break; if (_sp > XB_SPIN_CAP) { atomicAdd(&(bar)[XB_TMO], 1u); break; } } } } while (0)
struct XcdBarrier { unsigned* bar; unsigned x; volatile LAS unsigned* st; };
DI XcdBarrier xcd_barrier_post(unsigned* bar, volatile LAS unsigned* st) {
  XcdBarrier b; b.bar = bar; b.x = xb_xcc_id(); b.st = st;
  if (threadIdx.x == 0) (void)xb_add(&bar[XB_XCNT(b.x)], 1u);
  return b;
}
DI void xcd_barrier_complete(unsigned* bar, unsigned x, unsigned& nloc, unsigned& nx) {
  const unsigned G = gridDim.x;
  unsigned sum, cnt, mine, sp = 0u;
  for (;;) {
    sum = 0u; cnt = 0u; mine = 0u;
#pragma unroll
    for (unsigned j = 0; j < 16; ++j) { const unsigned c = xb_ld(&bar[XB_XCNT(j)]); sum += c; cnt += (c > 0u) ? 1u : 0u; mine = (j == x) ? c : mine; }
    if (sum == G) break;
    __builtin_amdgcn_s_sleep(1);
    if ((++sp & 255u) == 0u) { if (xb_ld(&bar[XB_TMO])) break; if (sp > XB_SPIN_CAP) { atomicAdd(&bar[XB_TMO], 1u); break; } }
  }
  nloc = mine > 0u ? mine : 1u; nx = cnt > 0u ? cnt : 1u;
}
DI void xcd_barrier(const XcdBarrier& b) {
  asm volatile("s_waitcnt vmcnt(0)" ::: "memory");
  __syncthreads();
  if (threadIdx.x == 0) {
    unsigned* bar = b.bar;
    __builtin_amdgcn_s_waitcnt(0);
    unsigned nloc = b.st[0], nx = b.st[1];
    if (nloc == 0u) { xcd_barrier_complete(bar, b.x, nloc, nx); b.st[0] = nloc; b.st[1] = nx; }
    const unsigned old = xb_add(&bar[XB_XSUB(b.x)], 1u);
    const unsigned gen = old / nloc;
    if (old + 1u == (gen + 1u) * nloc) {
      __builtin_amdgcn_fence(__ATOMIC_RELEASE, "agent");
      asm volatile("s_waitcnt vmcnt(0)" ::: "memory");
      const unsigned og = xb_add(&bar[XB_TOP], 1u);
      const unsigned tg = og / nx;
      if (og + 1u == (tg + 1u) * nx) xb_add(&bar[XB_TOPGEN], 1u);
      else XB_SPIN(xb_ld(&bar[XB_TOPGEN]) == tg, bar);
      __builtin_amdgcn_fence(__ATOMIC_ACQUIRE, "agent");
      xb_add(&bar[XB_XGEN(b.x)], 1u);
      asm volatile("s_waitcnt vmcnt(0)" ::: "memory");
    } else {
      XB_SPIN(xb_ld(&bar[XB_XGEN(b.x)]) == gen, bar);
      __builtin_amdgcn_fence(__ATOMIC_ACQUIRE, "agent");
      asm volatile("s_waitcnt vmcnt(0)" ::: "memory");
    }
  }
  __syncthreads();
}

template <int NB>
DI void gemm_tile(f32x4 (&acc)[4][NB], const u16* __restrict__ A, int lda, int row0, int lo, int hi,
                  const u16* __restrict__ W, int ldw, int K, char* smem) {
  const int tid = tidx(), lane = tid & 63, wid = tid >> 6, wr = wid >> 1, wc = wid & 1, fr = lane & 15, fq = lane >> 4;
  const int sr = tid >> 3, sc = tid & 7;
  uint4 ra0, ra1, ra2, ra3, rb0, rb1, rb2, rb3;
  rb0 = rb1 = rb2 = rb3 = make_uint4(0u, 0u, 0u, 0u);
#pragma unroll
  for (int m = 0; m < 4; ++m)
#pragma unroll
    for (int n = 0; n < NB; ++n) acc[m][n] = f32x4{0.f, 0.f, 0.f, 0.f};
  const int g0 = row0 + sr;
  const unsigned ma0 = (g0 >= lo && g0 < hi) ? 0xffffffffu : 0u, ma1 = (g0 + 32 >= lo && g0 + 32 < hi) ? 0xffffffffu : 0u;
  const unsigned ma2 = (g0 + 64 >= lo && g0 + 64 < hi) ? 0xffffffffu : 0u, ma3 = (g0 + 96 >= lo && g0 + 96 < hi) ? 0xffffffffu : 0u;
  const int c0r = min(max(g0, lo), hi - 1), c1r = min(max(g0 + 32, lo), hi - 1), c2r = min(max(g0 + 64, lo), hi - 1), c3r = min(max(g0 + 96, lo), hi - 1);
  const u16* ap0 = A + (size_t)c0r * lda + sc * 8;
  const u16* ap1 = A + (size_t)c1r * lda + sc * 8;
  const u16* ap2 = A + (size_t)c2r * lda + sc * 8;
  const u16* ap3 = A + (size_t)c3r * lda + sc * 8;
  const u16* wp = W + (size_t)sr * ldw + sc * 8;
  const size_t ws32 = (size_t)32 * ldw;
  int koff = 0;
  char* sw = smem + sr * 144 + sc * 16;
#define MSK(r, m) do { r.x &= m; r.y &= m; r.z &= m; r.w &= m; } while (0)
#define GLOAD() do { \
    ra0 = *(const uint4*)(ap0 + koff); ra1 = *(const uint4*)(ap1 + koff); ra2 = *(const uint4*)(ap2 + koff); ra3 = *(const uint4*)(ap3 + koff); \
    MSK(ra0, ma0); MSK(ra1, ma1); MSK(ra2, ma2); MSK(ra3, ma3); \
    rb0 = *(const uint4*)(wp + koff); rb1 = *(const uint4*)(wp + ws32 + koff); \
    if (NB > 2) { rb2 = *(const uint4*)(wp + 2 * ws32 + koff); rb3 = *(const uint4*)(wp + 3 * ws32 + koff); } \
    koff += 64; } while (0)
#define SWRITE(buf) do { char* b_ = sw + (buf) * 36864; \
    *(uint4*)(b_) = ra0; *(uint4*)(b_ + 32 * 144) = ra1; *(uint4*)(b_ + 64 * 144) = ra2; *(uint4*)(b_ + 96 * 144) = ra3; \
    *(uint4*)(b_ + 18432) = rb0; *(uint4*)(b_ + 18432 + 32 * 144) = rb1; \
    if (NB > 2) { *(uint4*)(b_ + 18432 + 64 * 144) = rb2; *(uint4*)(b_ + 18432 + 96 * 144) = rb3; } } while (0)
  GLOAD(); SWRITE(0); __syncthreads();
  const int nk = K >> 6;
#pragma unroll 1
  for (int kt = 0; kt < nk; ++kt) {
    if (kt + 1 < nk) GLOAD();
    const char* b = smem + (kt & 1) * 36864;
#pragma unroll
    for (int kk = 0; kk < 2; ++kk) {
      bf16x8 af[4], bfr[NB];
#pragma unroll
      for (int m = 0; m < 4; ++m) af[m] = *(const bf16x8*)(b + (wr * 64 + m * 16 + fr) * 144 + (kk * 32 + fq * 8) * 2);
#pragma unroll
      for (int n = 0; n < NB; ++n) bfr[n] = *(const bf16x8*)(b + 18432 + (wc * (NB * 16) + n * 16 + fr) * 144 + (kk * 32 + fq * 8) * 2);
#pragma unroll
      for (int m = 0; m < 4; ++m)
#pragma unroll
        for (int n = 0; n < NB; ++n) acc[m][n] = MFMA16(af[m], bfr[n], acc[m][n]);
    }
    if (kt + 1 < nk) SWRITE((kt + 1) & 1);
    __syncthreads();
  }
#undef GLOAD
#undef SWRITE
#undef MSK
}

constexpr int CTS = 132;
template <int NB>
DI void acc_to_lds(const f32x4 (&acc)[4][NB], float* Ct, const float* rs) {
  const int tid = tidx(), lane = tid & 63, wid = tid >> 6, wr = wid >> 1, wc = wid & 1, fr = lane & 15, fq = lane >> 4;
#pragma unroll
  for (int m = 0; m < 4; ++m)
#pragma unroll
    for (int j = 0; j < 4; ++j) {
      const int r = wr * 64 + m * 16 + fq * 4 + j;
      const float s = rs ? rs[r] : 1.f;
#pragma unroll
      for (int n = 0; n < NB; ++n) Ct[r * CTS + wc * (NB * 16) + n * 16 + fr] = acc[m][n][j] * s;
    }
  __syncthreads();
}

DI void conv_wtile(const float* __restrict__ src, int K, int N, u16* __restrict__ dst, const float* __restrict__ gain, int permute, int tile, float* tl) {
  const int tid = tidx();
  const int nnt = N >> 6; const int kt = tile / nnt, nt = tile - kt * nnt; const int k0 = kt * 64, n0 = nt * 64;
  {
    const int n = tid & 63, kq = tid >> 6;
#pragma unroll 4
    for (int i = 0; i < 16; ++i) { const int k = i * 4 + kq; float v = src[(size_t)(k0 + k) * N + n0 + n]; if (gain) v *= gain[k0 + k]; tl[k * 65 + n] = v; }
  }
  __syncthreads();
#pragma unroll
  for (int j = 0; j < 2; ++j) {
    const int n = (tid >> 3) + 32 * j, ks = tid & 7;
    float v[8];
#pragma unroll
    for (int q = 0; q < 8; ++q) v[q] = tl[(ks * 8 + q) * 65 + n];
    int nn = n0 + n;
    if (permute) nn = (nn < DFF) ? ((nn >> 6) * 128 + (nn & 63)) : ((((nn - DFF) >> 6) * 128) + 64 + ((nn - DFF) & 63));
    uint4 pk = make_uint4(pack2(v[0], v[1]), pack2(v[2], v[3]), pack2(v[4], v[5]), pack2(v[6], v[7]));
    *(uint4*)(dst + (size_t)nn * K + k0 + ks * 8) = pk;
  }
  __syncthreads();
}
constexpr int NCONV_MIX = 1856 + 3 * 128 + 256;
constexpr int NCONV_FFN = 1408 + 704;
DI void conv_wmix_item(const Params& p, int l, int it, char* smem) {
  float* tl = (float*)smem; unsigned char* ws = p.ws;
  if (it < 1856) conv_wtile(p.in[9] + (size_t)l * 1024 * INW, 1024, INW, (u16*)(ws + OFF_WIN), p.in[8] + l * 1024, 0, it, tl);
  else if (it < 1856 + 384) { const int b = (it - 1856) >> 7, t = (it - 1856) & 127;
    conv_wtile(p.in[14 + b] + (size_t)l * 512 * 1024, 512, 1024, (u16*)(ws + OFF_WA + b * W_BR_B), nullptr, 0, t, tl); }
  else conv_wtile(p.in[17] + (size_t)l * 1024 * 1024, 1024, 1024, (u16*)(ws + OFF_WOUT), nullptr, 0, it - 2240, tl);
}
DI void conv_wffn_item(const Params& p, int l, int it, char* smem) {
  float* tl = (float*)smem; unsigned char* ws = p.ws;
  if (it < 1408) conv_wtile(p.in[19] + (size_t)l * 1024 * DFF2, 1024, DFF2, (u16*)(ws + OFF_WUP), p.in[18] + l * 1024, 1, it, tl);
  else conv_wtile(p.in[22] + (size_t)l * DFF * 1024, DFF, 1024, (u16*)(ws + OFF_WDOWN), nullptr, 0, it - 1408, tl);
}

DI void phase0(const Params& p, char* smem) {
  const int tid = tidx(), lane = tid & 63, wid = tid >> 6;
  float* x = p.out; u16* xb = (u16*)(p.ws + OFF_XB);
  float* rowsq1 = (float*)(p.ws + OFF_ROWSQ1); float* rowsq2 = (float*)(p.ws + OFF_ROWSQ2);
  for (int it = blockIdx.x; it < T / 4; it += gridDim.x) {
    const int row = it * 4 + wid;
    const float* src = row < TP ? p.in[0] + (size_t)row * 1024 : p.in[1] + (size_t)(row - TP) * 1024;
    float ss = 0.f;
#pragma unroll
    for (int i = 0; i < 4; ++i) {
      const int c = (i * 64 + lane) * 4;
      const float4 v = *(const float4*)(src + c);
      *(float4*)(x + (size_t)row * 1024 + c) = v;
      ss += v.x * v.x + v.y * v.y + v.z * v.z + v.w * v.w;
      *(uint2*)(xb + (size_t)row * 1024 + c) = make_uint2(pack2(v.x, v.y), pack2(v.z, v.w));
    }
    ss = wave_sum(ss);
    if (lane == 0) { rowsq1[row] = ss; rowsq2[row] = 0.f; }
  }
  for (int it = blockIdx.x; it < NCONV_MIX; it += gridDim.x) conv_wmix_item(p, 0, it, smem);
  const size_t gsz = (size_t)gridDim.x * NT, g0 = (size_t)blockIdx.x * NT + tid;
  for (size_t e = g0; e < (size_t)2 * 8 * 64 * 128; e += gsz) {
    const size_t lb = e / (64 * 128), r = e % (64 * 128);
    p.out[O_AKS + lb * 128 * 128 + r] = p.in[2][lb * 128 * 128 + 64 * 128 + r];
    p.out[O_AVS + lb * 128 * 128 + r] = p.in[3][lb * 128 * 128 + 64 * 128 + r];
  }
  for (size_t e = g0; e < (size_t)2 * 8 * 448 * 512 / 4; e += gsz) {
    const size_t e4 = e * 4; const size_t lb = e4 / (448 * 512), r = e4 % (448 * 512);
    *(float4*)(p.out + O_BKS + lb * 512 * 512 + r) = *(const float4*)(p.in[4] + lb * 512 * 512 + 64 * 512 + r);
    *(float4*)(p.out + O_BVS + lb * 512 * 512 + r) = *(const float4*)(p.in[5] + lb * 512 * 512 + 64 * 512 + r);
  }
}

DI void cache_to_kv(const Params& p, int l) {
  const int tid = tidx();
  const size_t gsz = (size_t)gridDim.x * NT, g0 = (size_t)blockIdx.x * NT + tid;
  u16* Ka = (u16*)(p.ws + OFF_KA); u16* Vta = (u16*)(p.ws + OFF_VTA); u16* Kb = (u16*)(p.ws + OFF_KB); u16* Vtb = (u16*)(p.ws + OFF_VTB);
  for (size_t e = g0; e < (size_t)8 * 128 * 128 / 8; e += gsz) {
    const size_t e8 = e * 8; const int b = (int)(e8 / (128 * 128)); const int j = (int)((e8 / 128) % 128), c = (int)(e8 % 128);
    const float* s = p.in[2] + ((size_t)(l * 8 + b) * 128 + j) * 128 + c;
    const float4 v0 = *(const float4*)s, v1 = *(const float4*)(s + 4);
    *(uint4*)(Ka + (size_t)(TP + b * 192 + j) * 128 + c) = make_uint4(pack2(v0.x, v0.y), pack2(v0.z, v0.w), pack2(v1.x, v1.y), pack2(v1.z, v1.w));
  }
  for (size_t e = g0; e < (size_t)8 * 512 * 512 / 8; e += gsz) {
    const size_t e8 = e * 8; const int b = (int)(e8 / (512 * 512)); const int j = (int)((e8 / 512) % 512), c = (int)(e8 % 512);
    const float* s = p.in[4] + ((size_t)(l * 8 + b) * 512 + j) * 512 + c;
    const float4 v0 = *(const float4*)s, v1 = *(const float4*)(s + 4);
    *(uint4*)(Kb + (size_t)(TP + b * 576 + j) * 512 + c) = make_uint4(pack2(v0.x, v0.y), pack2(v0.z, v0.w), pack2(v1.x, v1.y), pack2(v1.z, v1.w));
  }
  for (size_t e = g0; e < (size_t)8 * 16 * 128; e += gsz) {
    const int c = (int)(e % 128), j8 = (int)((e / 128) % 16), b = (int)(e / (128 * 16));
    const float* s = p.in[3] + ((size_t)(l * 8 + b) * 128 + j8 * 8) * 128 + c;
    float v[8];
#pragma unroll
    for (int q = 0; q < 8; ++q) v[q] = s[(size_t)q * 128];
    *(uint4*)(Vta + (size_t)c * KA_ROWS + TP + b * 192 + j8 * 8) = make_uint4(pack2(v[0], v[1]), pack2(v[2], v[3]), pack2(v[4], v[5]), pack2(v[6], v[7]));
  }
  for (size_t e = g0; e < (size_t)8 * 64 * 512; e += gsz) {
    const int c = (int)(e % 512), j8 = (int)((e / 512) % 64), b = (int)(e / (512 * 64));
    const float* s = p.in[5] + ((size_t)(l * 8 + b) * 512 + j8 * 8) * 512 + c;
    float v[8];
#pragma unroll
    for (int q = 0; q < 8; ++q) v[q] = s[(size_t)q * 512];
    *(uint4*)(Vtb + (size_t)c * KB_ROWS + TP + b * 576 + j8 * 8) = make_uint4(pack2(v[0], v[1]), pack2(v[2], v[3]), pack2(v[4], v[5]), pack2(v[6], v[7]));
  }
}

DI void p1_tile(const Params& p, int l, int rt, int ct, char* smem) {
  const int tid = tidx();
  unsigned char* ws = p.ws;
  float* Ct = (float*)smem; float* rs = (float*)(smem + 73728);
  const float* rowsq1 = (const float*)(ws + OFF_ROWSQ1);
  const int row0 = rt * 128;
  if (tid < 128) rs[tid] = rsqrtf(rowsq1[row0 + tid] * (1.f / 1024.f) + EPS);
  f32x4 acc[4][4];
  gemm_tile<4>(acc, (const u16*)(ws + OFF_XB), 1024, row0, 0, T, (const u16*)(ws + OFF_WIN) + (size_t)ct * 128 * 1024, 1024, 1024, smem);
  acc_to_lds<4>(acc, Ct, rs);
  int kind, cb;
  u16* dst; int dstw;
  bool isB = false; int hplane = 0;
  if (ct < 4)       { kind = 0; cb = ct * 128;        dst = (u16*)(ws + OFF_QA); dstw = 512; }
  else if (ct == 4) { kind = 1; cb = 0;               dst = (u16*)(ws + OFF_KA); dstw = 128; }
  else if (ct == 5) { kind = 2; cb = 0;               dst = (u16*)(ws + OFF_VTA); dstw = 128; }
  else if (ct < 10) { kind = 3; cb = (ct - 6) * 128;  dst = (u16*)(ws + OFF_QB); dstw = 512; isB = true; }
  else if (ct < 14) { kind = 4; cb = (ct - 10) * 128; dst = (u16*)(ws + OFF_KB); dstw = 512; isB = true; }
  else if (ct < 18) { kind = 2; cb = (ct - 14) * 128; dst = (u16*)(ws + OFF_VTB); dstw = 512; isB = true; }
  else { kind = 3; hplane = (ct - 18) >> 2; cb = ((ct - 18) & 3) * 128; dst = (u16*)(ws + OFF_HF + (size_t)hplane * PLANE); dstw = 512; }
  const bool rope = (kind == 0 || kind == 1);
  const bool iskv = (kind == 1 || kind == 2 || kind == 4);
  const int R = isB ? 512 : 128;
  float* cache_p = nullptr; float* cache_s = nullptr;
  if (iskv) {
    const bool isv = (kind == 2);
    cache_p = p.out + (isB ? (isv ? O_BVP : O_BKP) : (isv ? O_AVP : O_AKP)) + (size_t)l * R * dstw;
    cache_s = p.out + (isB ? (isv ? O_BVS : O_BKS) : (isv ? O_AVS : O_AKS)) + (size_t)l * 8 * R * dstw;
  }
#pragma unroll 1
  for (int i = 0; i < 4; ++i) {
    const int item = tid + NT * i; const int r = item >> 3, g = item & 7;
    const int tok = row0 + r;
    float v[16];
#pragma unroll
    for (int q = 0; q < 4; ++q) { const float4 t4 = *(const float4*)(Ct + r * CTS + g * 16 + q * 4); v[q * 4] = t4.x; v[q * 4 + 1] = t4.y; v[q * 4 + 2] = t4.z; v[q * 4 + 3] = t4.w; }
    if (rope && (g & 3) == 0) {
      const float pos = (float)(tok < TP ? tok : 1024 + ((tok - TP) & 63));
#pragma unroll
      for (int d = 0; d < 8; ++d) {
        const float invf = exp2f(-(float)d * (18.931568569324174f / 8.f));
        float sn, cs; sincosf(pos * invf, &sn, &cs);
        const float x1 = v[d], x2 = v[d + 8];
        v[d] = x1 * cs - x2 * sn; v[d + 8] = x2 * cs + x1 * sn;
      }
    }
    const int col = cb + g * 16;
    if (kind != 2) {
      size_t drow;
      if (kind == 1) drow = (size_t)krowA(tok); else if (kind == 4) drow = (size_t)krowB(tok); else drow = (size_t)tok;
      u16* d = dst + drow * dstw + col;
      *(uint4*)d = make_uint4(pack2(v[0], v[1]), pack2(v[2], v[3]), pack2(v[4], v[5]), pack2(v[6], v[7]));
      *(uint4*)(d + 8) = make_uint4(pack2(v[8], v[9]), pack2(v[10], v[11]), pack2(v[12], v[13]), pack2(v[14], v[15]));
    }
    if (iskv) {
      float* cd = nullptr;
      if (tok < TP) { if (tok >= TP - R) cd = cache_p + (size_t)(tok - (TP - R)) * dstw + col; }
      else { const int s = tok - TP; cd = cache_s + ((size_t)(s >> 6) * R + (R - 64) + (s & 63)) * dstw + col; }
      if (cd) {
#pragma unroll
        for (int q = 0; q < 4; ++q) *(float4*)(cd + q * 4) = make_float4(v[q * 4], v[q * 4 + 1], v[q * 4 + 2], v[q * 4 + 3]);
      }
    }
  }
  if (kind == 2) {
    const int ROWS = isB ? KB_ROWS : KA_ROWS;
#pragma unroll 1
    for (int i = 0; i < 8; ++i) {
      const int item = tid + NT * i; const int g8 = item & 15, c = item >> 4;
      float v[8];
#pragma unroll
      for (int q = 0; q < 8; ++q) v[q] = Ct[(g8 * 8 + q) * CTS + c];
      const int tok = row0 + g8 * 8;
      const int kr = isB ? krowB(tok) : krowA(tok);
      *(uint4*)(dst + (size_t)(cb + c) * ROWS + kr) = make_uint4(pack2(v[0], v[1]), pack2(v[2], v[3]), pack2(v[4], v[5]), pack2(v[6], v[7]));
    }
  }
  __syncthreads();
}

template <int NG, bool ISB>
DI void attn_item(const Params& p, int l, int sc, int h, char* smem) {
  const int lane = tidx() & 63, wid = tidx() >> 6, fr = lane & 15, fq = lane >> 4;
  constexpr int KW = ISB ? 512 : 128;
  constexpr int KROWS = ISB ? KB_ROWS : KA_ROWS;
  constexpr int R = ISB ? 512 : 128;
  u16* Q = (u16*)(p.ws + (ISB ? OFF_QB : OFF_QA));
  const u16* Kp = (const u16*)(p.ws + (ISB ? OFF_KB : OFF_KA));
  const u16* Vt = (const u16*)(p.ws + (ISB ? OFF_VTB : OFF_VTA));
  int tokq0, kband0, firstblk;
  if (sc < 256) { tokq0 = sc * 64; kband0 = sc * 64 - R; firstblk = kband0 < 0 ? ((-kband0) >> 4) : 0; }
  else { const int b = sc - 256; tokq0 = TP + b * 64; kband0 = TP + b * (R + 64); firstblk = 0; }
  const int hk = ISB ? h : (h >> 2);
  const int qrow = tokq0 + wid * 16 + fr;
  bf16x8 qf[2];
#pragma unroll
  for (int kk = 0; kk < 2; ++kk) qf[kk] = *(const bf16x8*)(Q + (size_t)qrow * 512 + h * 64 + kk * 32 + fq * 8);
  const float* table = (const float*)smem;
  float tconst = 0.f;
  if (ISB) {
    const float* gt = p.in[11] + (size_t)(l * 8 + h) * 257;
    float* tw = (float*)smem;
    const int t_ = tidx();
    __syncthreads();
    tw[t_] = gt[t_]; if (t_ == 0) tw[256] = gt[256];
    __syncthreads();
    tconst = table[256];
  }
  const int qi = wid * 16 + fr;
  float m_run, l_run;
  if (ISB) { m_run = -1e30f; l_run = 0.f; } else { m_run = p.in[10][l * 8 + h]; l_run = 1.f; }
  f32x4 o[4];
#pragma unroll
  for (int d = 0; d < 4; ++d) o[d] = f32x4{0.f, 0.f, 0.f, 0.f};
#pragma unroll 1
  for (int g = 0; g < NG; ++g) {
    const int fb = firstblk - g * 12;
    if (fb >= 12) continue;
    const int kb0 = kband0 + g * 192;
    f32x4 s[12];
#pragma unroll
    for (int blk = 0; blk < 12; ++blk) {
      f32x4 a = {0.f, 0.f, 0.f, 0.f};
      if (blk == 6) asm volatile("" ::: "memory");
      if (blk >= fb) {
        const u16* kr = Kp + (size_t)(kb0 + blk * 16 + fr) * KW + hk * 64 + fq * 8;
        const bf16x8 k0 = *(const bf16x8*)kr, k1 = *(const bf16x8*)(kr + 32);
        a = MFMA16(k0, qf[0], a); a = MFMA16(k1, qf[1], a);
      }
      s[blk] = a;
    }
    float mx = -1e30f;
#pragma unroll
    for (int blk = 0; blk < 12; ++blk) {
#pragma unroll
      for (int j = 0; j < 4; ++j) {
        float v = s[blk][j] * 0.125f;
        if (ISB) {
          if (g < 2) v += tconst;
          else { int rel = 128 + qi - (blk * 16 + fq * 4 + j); rel = rel < -128 ? -128 : (rel > 128 ? 128 : rel); v += table[rel + 128]; }
        }
        if (blk < fb) v = -1e30f;
        s[blk][j] = v; mx = fmaxf(mx, v);
      }
    }
    mx = fmaxf(mx, __shfl_xor(mx, 16, 64)); mx = fmaxf(mx, __shfl_xor(mx, 32, 64));
    const float m_new = fmaxf(m_run, mx);
    const float scale = __expf(m_run - m_new);
    m_run = m_new;
    float sum = 0.f;
#pragma unroll
    for (int blk = 0; blk < 12; ++blk)
#pragma unroll
      for (int j = 0; j < 4; ++j) { const float e = __expf(s[blk][j] - m_new); s[blk][j] = e; sum += e; }
    sum += __shfl_xor(sum, 16, 64); sum += __shfl_xor(sum, 32, 64);
    l_run = l_run * scale + sum;
#pragma unroll
    for (int d = 0; d < 4; ++d) { o[d][0] *= scale; o[d][1] *= scale; o[d][2] *= scale; o[d][3] *= scale; }
#pragma unroll
    for (int pp = 0; pp < 6; ++pp) {
      if (pp == 2 || pp == 4) asm volatile("" ::: "memory");
      if (2 * pp >= fb) {
        uint4 pk = make_uint4(pack2(s[2 * pp][0], s[2 * pp][1]), pack2(s[2 * pp][2], s[2 * pp][3]),
                              pack2(s[2 * pp + 1][0], s[2 * pp + 1][1]), pack2(s[2 * pp + 1][2], s[2 * pp + 1][3]));
        const bf16x8 pb = __builtin_bit_cast(bf16x8, pk);
#pragma unroll
        for (int d = 0; d < 4; ++d) {
          const u16* vr = Vt + (size_t)(hk * 64 + d * 16 + fr) * KROWS + kb0 + pp * 32 + fq * 4;
          const uint2 lo = *(const uint2*)vr, hi = *(const uint2*)(vr + 16);
          const bf16x8 va = __builtin_bit_cast(bf16x8, make_uint4(lo.x, lo.y, hi.x, hi.y));
          o[d] = MFMA16(va, pb, o[d]);
        }
      }
    }
  }
  const float inv = 1.f / l_run;
#pragma unroll
  for (int d = 0; d < 4; ++d)
    *(uint2*)(Q + (size_t)qrow * 512 + h * 64 + d * 16 + fq * 4) = make_uint2(pack2(o[d][0] * inv, o[d][1] * inv), pack2(o[d][2] * inv, o[d][3] * inv));
}

constexpr int HS = 20;
template <bool OUT>
DI void hgrn_item(const Params& p, int l, int cidx, int h, char* smem) {
  const int tid = tidx(), v = tid & 127, half = tid >> 7;
  unsigned char* ws = p.ws;
  float* qdT = (float*)smem;
  float* kdT = qdT + 128 * HS;
  float* kpT = kdT + 128 * HS;
  float* vS = kpT + 128 * HS;
  float* ob0 = vS + 2048;
  float* AsT = ob0 + 4096;
  float* tot = AsT + 256;
  float* dec = tot + 256;
  const u16* Hf = (const u16*)(ws + OFF_HF); const u16* Hi = (const u16*)(ws + OFF_HI);
  u16* Hq = (u16*)(ws + OFF_HQ); const u16* Hog = (const u16*)(ws + OFF_HOG);
  const bool sample = OUT && cidx >= 128;
  const int tok_base = sample ? TP + (cidx - 128) * 64 : cidx * 128;
  const int nsb = sample ? 4 : 8;
  float lb = 0.f;
  { const int k = tid & 127; if (l == 1) lb = sigmoidf_(p.in[12][512 + h * 128 + k] - p.in[12][h * 128 + k]); }
  float S[64];
  if (OUT) {
    const float* s0 = sample ? p.in[6] + ((size_t)(l * 8 + (cidx - 128)) * 4 + h) * 16384
                             : (const float*)(ws + OFF_ST) + ((size_t)cidx * 4 + h) * 16384;
    const float* ps = s0 + (size_t)(half * 64) * 128 + v;
#pragma unroll
    for (int kk = 0; kk < 64; ++kk) {
      if ((kk & 7) == 0) asm volatile("" : "+v"(ps));
      S[kk] = ps[(kk & 7) * 128];
      if ((kk & 7) == 7) ps += 8 * 128;
    }
  } else {
#pragma unroll
    for (int kk = 0; kk < 64; ++kk) S[kk] = 0.f;
  }
  float lastsum = 0.f;
#pragma unroll 1
  for (int sb = 0; sb < nsb; ++sb) {
    const int tok0 = tok_base + sb * 16;
    __syncthreads();
    float lf[8], kk8[8], q8[8];
    {
      const int k = v;
      float run = 0.f;
#pragma unroll
      for (int i = 0; i < 8; ++i) {
        const size_t off = (size_t)(tok0 + half * 8 + i) * 512 + h * 128 + k;
        const float z = bf2f(Hf[off]);
        const float e = __expf(-fabsf(z));
        const float sp = 1.f / (1.f + e);
        const float sig = z >= 0.f ? sp : e * sp;
        const float nsig = z >= 0.f ? e * sp : sp;
        float lfi;
        if (lb > 0.f) lfi = __logf(lb + (1.f - lb) * sig);
        else lfi = fminf(z, 0.f) - log1pf(e);
        run += lfi; lf[i] = run;
        kk8[i] = (1.f - lb) * nsig;
        if (OUT) { const float qp = bf2f(Hq[off]); q8[i] = qp * sigmoidf_(qp); } else q8[i] = 0.f;
        vS[(half * 8 + i) * 128 + k] = bf2f(Hi[off]);
      }
      tot[half * 128 + k] = run;
    }
    __syncthreads();
    {
      const int k = v;
      const float t0 = tot[k], t1 = tot[128 + k];
      const float last = t0 + t1, base = half ? t0 : 0.f;
      float qd[8], kd[8], kp[8];
#pragma unroll
      for (int i = 0; i < 8; ++i) {
        const float cum = base + lf[i];
        qd[i] = q8[i] * __expf(cum);
        kd[i] = kk8[i] * __expf(last - cum);
        kp[i] = kk8[i] * __expf(fminf(-cum, 80.f));
      }
      float* d0 = kdT + k * HS + half * 8;
      *(float4*)d0 = make_float4(kd[0], kd[1], kd[2], kd[3]); *(float4*)(d0 + 4) = make_float4(kd[4], kd[5], kd[6], kd[7]);
      if (OUT) {
        float* d1 = qdT + k * HS + half * 8; float* d2 = kpT + k * HS + half * 8;
        *(float4*)d1 = make_float4(qd[0], qd[1], qd[2], qd[3]); *(float4*)(d1 + 4) = make_float4(qd[4], qd[5], qd[6], qd[7]);
        *(float4*)d2 = make_float4(kp[0], kp[1], kp[2], kp[3]); *(float4*)(d2 + 4) = make_float4(kp[4], kp[5], kp[6], kp[7]);
      }
      if (half == 0) dec[k] = __expf(last);
      lastsum += last;
    }
    __syncthreads();
    float vreg[16];
#pragma unroll
    for (int t = 0; t < 16; ++t) vreg[t] = vS[t * 128 + v];
    if (OUT) {
#ifndef HX3
      {
        const int t = tid >> 4, s = tid & 15;
        float a = 0.f;
#pragma unroll 8
        for (int k = 0; k < 128; ++k) a += qdT[k * HS + t] * kpT[k * HS + s];
        AsT[s * 16 + t] = (s <= t) ? a : 0.f;
      }
#endif
      float o[16];
#pragma unroll
      for (int t = 0; t < 16; ++t) o[t] = 0.f;
#ifndef HX4
#pragma unroll
      for (int kk = 0; kk < 64; ++kk) {
        asm volatile("" ::: "memory");
        const float* qr = qdT + (half * 64 + kk) * HS;
        const float sv = S[kk];
#pragma unroll
        for (int q = 0; q < 4; ++q) { const float4 t4 = *(const float4*)(qr + q * 4); o[q * 4] += sv * t4.x; o[q * 4 + 1] += sv * t4.y; o[q * 4 + 2] += sv * t4.z; o[q * 4 + 3] += sv * t4.w; }
      }
#endif
      __syncthreads();
#pragma unroll
      for (int si = 0; si < 8; ++si) {
        const int s = half * 8 + si;
        const float vs = vreg[s];
        const float* ar = AsT + s * 16;
#pragma unroll
        for (int q = 0; q < 4; ++q) { const float4 t4 = *(const float4*)(ar + q * 4); o[q * 4] += vs * t4.x; o[q * 4 + 1] += vs * t4.y; o[q * 4 + 2] += vs * t4.z; o[q * 4 + 3] += vs * t4.w; }
      }
      float* ob = ob0 + half * 2048;
#pragma unroll
      for (int t = 0; t < 16; ++t) ob[t * 128 + v] = o[t];
      __syncthreads();
#ifndef HX6
      {
        const int t = tid >> 4, seg = tid & 15;
        float ov[8];
        const float4 a0 = *(const float4*)(ob0 + t * 128 + seg * 8), a1 = *(const float4*)(ob0 + t * 128 + seg * 8 + 4);
        const float4 b0 = *(const float4*)(ob0 + 2048 + t * 128 + seg * 8), b1 = *(const float4*)(ob0 + 2048 + t * 128 + seg * 8 + 4);
        ov[0] = a0.x + b0.x; ov[1] = a0.y + b0.y; ov[2] = a0.z + b0.z; ov[3] = a0.w + b0.w;
        ov[4] = a1.x + b1.x; ov[5] = a1.y + b1.y; ov[6] = a1.z + b1.z; ov[7] = a1.w + b1.w;
        float ss = 0.f;
#pragma unroll
        for (int q = 0; q < 8; ++q) ss += ov[q] * ov[q];
        ss += __shfl_xor(ss, 1, 64); ss += __shfl_xor(ss, 2, 64); ss += __shfl_xor(ss, 4, 64); ss += __shfl_xor(ss, 8, 64);
        const float rn = rsqrtf(ss * (1.f / 128.f) + EPS);
        const size_t off = (size_t)(tok0 + t) * 512 + h * 128 + seg * 8;
        const uint4 ogp = *(const uint4*)(Hog + off);
        const unsigned ogw[4] = {ogp.x, ogp.y, ogp.z, ogp.w};
        const float* cn = p.in[13] + l * 512 + h * 128 + seg * 8;
        float r8[8];
#pragma unroll
        for (int q = 0; q < 8; ++q) {
          const float g = (q & 1) ? hi_f(ogw[q >> 1]) : lo_f(ogw[q >> 1]);
          r8[q] = ov[q] * rn * cn[q] * (g * sigmoidf_(g));
        }
        *(uint4*)(Hq + off) = make_uint4(pack2(r8[0], r8[1]), pack2(r8[2], r8[3]), pack2(r8[4], r8[5]), pack2(r8[6], r8[7]));
      }
#endif
    }
#ifndef HX7
#pragma unroll
    for (int kk = 0; kk < 64; ++kk) {
      asm volatile("" ::: "memory");
      const int k = half * 64 + kk;
      const float* kr = kdT + k * HS;
      float a = dec[k] * S[kk];
#pragma unroll
      for (int q = 0; q < 4; ++q) { const float4 t4 = *(const float4*)(kr + q * 4); a += t4.x * vreg[q * 4] + t4.y * vreg[q * 4 + 1] + t4.z * vreg[q * 4 + 2] + t4.w * vreg[q * 4 + 3]; }
      S[kk] = a;
    }
#endif
  }
  if (!OUT) {
    float* D = (float*)(ws + OFF_ST) + ((size_t)cidx * 4 + h) * 16384 + (size_t)(half * 64) * 128 + v;
#pragma unroll
    for (int kk = 0; kk < 64; ++kk) {
      if ((kk & 7) == 0) asm volatile("" : "+v"(D));
      D[(kk & 7) * 128] = S[kk];
      if ((kk & 7) == 7) D += 8 * 128;
    }
    if (half == 0) ((float*)(ws + OFF_DECAY))[((size_t)cidx * 4 + h) * 128 + v] = __expf(lastsum);
  } else if (sample) {
    float* D = p.out + O_CS + ((size_t)(l * 8 + (cidx - 128)) * 4 + h) * 16384 + (size_t)(half * 64) * 128 + v;
#pragma unroll
    for (int kk = 0; kk < 64; ++kk) {
      if ((kk & 7) == 0) asm volatile("" : "+v"(D));
      D[(kk & 7) * 128] = S[kk];
      if ((kk & 7) == 7) D += 8 * 128;
    }
  }
  __syncthreads();
}

DI void hgrn_scan(const Params& p, int l) {
  float* ST = (float*)(p.ws + OFF_ST); const float* DEC = (const float*)(p.ws + OFF_DECAY);
  for (int e = blockIdx.x * NT + tidx(); e < 65536; e += gridDim.x * NT) {
    const int h = e >> 14, k = (e >> 7) & 127;
    float S = 0.f;
    float* ptr = ST + (size_t)h * 16384 + (e & 16383);
    const float* dp = DEC + h * 128 + k;
#pragma unroll 1
    for (int c0 = 0; c0 < 128; c0 += 8) {
      float d[8], dc[8];
#pragma unroll
      for (int i = 0; i < 8; ++i) { d[i] = ptr[(size_t)(c0 + i) * 65536]; dc[i] = dp[(c0 + i) * 512]; }
#pragma unroll
      for (int i = 0; i < 8; ++i) { ptr[(size_t)(c0 + i) * 65536] = S; S = dc[i] * S + d[i]; }
    }
    p.out[O_CP + (size_t)l * 65536 + e] = S;
  }
}

DI void p5_tile(const Params& p, int l, int rt, int ct, char* smem) {
  const int tid = tidx(), lane = tid & 63, wid = tid >> 6, wr = wid >> 1, fq = lane >> 4;
  unsigned char* ws = p.ws;
  float* Ct = (float*)smem; float* rs = (float*)(smem + 73728);
  const float* rowsq1 = (const float*)(ws + OFF_ROWSQ1);
  const int row0 = rt * 128, c0 = ct * 64;
  __syncthreads();
  if (tid < 128) rs[tid] = rsqrtf(rowsq1[row0 + tid] * (1.f / 1024.f) + EPS);
  f32x4 mix[4][2];
#pragma unroll
  for (int m = 0; m < 4; ++m)
#pragma unroll
    for (int n = 0; n < 2; ++n) mix[m][n] = f32x4{0.f, 0.f, 0.f, 0.f};
#pragma unroll 1
  for (int br = 0; br < 3; ++br) {
    f32x4 acc[4][2];
    gemm_tile<2>(acc, (const u16*)(ws + OFF_XB), 1024, row0, 0, T, (const u16*)(ws + OFF_WIN) + (size_t)(NIN1 + br * 1024 + c0) * 1024, 1024, 1024, smem);
    uint2 sg[4][2];
#pragma unroll
    for (int m = 0; m < 4; ++m) {
      const float4 r4 = *(const float4*)(rs + wr * 64 + m * 16 + fq * 4);
#pragma unroll
      for (int n = 0; n < 2; ++n)
        sg[m][n] = make_uint2(pack2(sigmoidf_(acc[m][n][0] * r4.x), sigmoidf_(acc[m][n][1] * r4.y)),
                              pack2(sigmoidf_(acc[m][n][2] * r4.z), sigmoidf_(acc[m][n][3] * r4.w)));
    }
    const u16* Ob = (const u16*)(ws + (br == 0 ? OFF_QA : (br == 1 ? OFF_QB : OFF_HQ)));
    gemm_tile<2>(acc, Ob, 512, row0, 0, T, (const u16*)(ws + OFF_WA + br * W_BR_B) + (size_t)c0 * 512, 512, 512, smem);
#pragma unroll
    for (int m = 0; m < 4; ++m)
#pragma unroll
      for (int n = 0; n < 2; ++n)
      {
        mix[m][n][0] += lo_f(sg[m][n].x) * acc[m][n][0]; mix[m][n][1] += hi_f(sg[m][n].x) * acc[m][n][1];
        mix[m][n][2] += lo_f(sg[m][n].y) * acc[m][n][2]; mix[m][n][3] += hi_f(sg[m][n].y) * acc[m][n][3];
      }
  }
  acc_to_lds<2>(mix, Ct, nullptr);
  u16* mixb = (u16*)(ws + OFF_MIX);
#pragma unroll 1
  for (int i = 0; i < 2; ++i) {
    const int item = tid + NT * i; const int r = item >> 2, g = item & 3;
    float v[16];
#pragma unroll
    for (int q = 0; q < 4; ++q) { const float4 t4 = *(const float4*)(Ct + r * CTS + g * 16 + q * 4); v[q * 4] = t4.x; v[q * 4 + 1] = t4.y; v[q * 4 + 2] = t4.z; v[q * 4 + 3] = t4.w; }
    u16* d = mixb + (size_t)(row0 + r) * 1024 + c0 + g * 16;
    *(uint4*)d = make_uint4(pack2(v[0], v[1]), pack2(v[2], v[3]), pack2(v[4], v[5]), pack2(v[6], v[7]));
    *(uint4*)(d + 8) = make_uint4(pack2(v[8], v[9]), pack2(v[10], v[11]), pack2(v[12], v[13]), pack2(v[14], v[15]));
  }
  __syncthreads();
}

DI void resid_tile(const Params& p, const u16* A, int lda, const u16* W, int K, float* rowsq, int rt, int ct, char* smem) {
  const int tid = tidx();
  float* Ct = (float*)smem;
  const int row0 = rt * 128, c0 = ct * 128;
  f32x4 acc[4][4];
  gemm_tile<4>(acc, A, lda, row0, 0, T, W + (size_t)c0 * K, K, K, smem);
  acc_to_lds<4>(acc, Ct, nullptr);
  float* x = p.out; u16* xb = (u16*)(p.ws + OFF_XB);
#pragma unroll 1
  for (int i = 0; i < 4; ++i) {
    const int item = tid + NT * i; const int r = item >> 3, g = item & 7;
    float* xp = x + (size_t)(row0 + r) * 1024 + c0 + g * 16;
    float v[16]; float ss = 0.f;
#pragma unroll
    for (int q = 0; q < 4; ++q) {
      const float4 t4 = *(const float4*)(Ct + r * CTS + g * 16 + q * 4); float4 x4 = *(const float4*)(xp + q * 4);
      x4.x += t4.x; x4.y += t4.y; x4.z += t4.z; x4.w += t4.w;
      *(float4*)(xp + q * 4) = x4;
      v[q * 4] = x4.x; v[q * 4 + 1] = x4.y; v[q * 4 + 2] = x4.z; v[q * 4 + 3] = x4.w;
      ss += x4.x * x4.x + x4.y * x4.y + x4.z * x4.z + x4.w * x4.w;
    }
    u16* d = xb + (size_t)(row0 + r) * 1024 + c0 + g * 16;
    *(uint4*)d = make_uint4(pack2(v[0], v[1]), pack2(v[2], v[3]), pack2(v[4], v[5]), pack2(v[6], v[7]));
    *(uint4*)(d + 8) = make_uint4(pack2(v[8], v[9]), pack2(v[10], v[11]), pack2(v[12], v[13]), pack2(v[14], v[15]));
    ss += __shfl_xor(ss, 1, 64); ss += __shfl_xor(ss, 2, 64); ss += __shfl_xor(ss, 4, 64);
    if (g == 0) atomicAdd(rowsq + row0 + r, ss);
  }
  __syncthreads();
}

DI float gelu_tanh(float g) { const float u = 0.7978845608028654f * (g + 0.044715f * g * g * g); return 0.5f * g * (1.f + tanhf(u)); }
DI void p7_tile(const Params& p, int l, int rt, int ct, char* smem) {
  const int tid = tidx();
  unsigned char* ws = p.ws;
  float* Ct = (float*)smem; float* rs = (float*)(smem + 73728);
  const float* rowsq2 = (const float*)(ws + OFF_ROWSQ2);
  const bool sample = rt >= 131;
  const int base = sample ? TP + (rt - 131) * 128 : rt * 126 - 2;
  const int lo = sample ? TP : 0, hi = sample ? T : TP;
  __syncthreads();
  if (tid < 128) { const int g = base + tid; rs[tid] = (g >= lo && g < hi) ? rsqrtf(rowsq2[g] * (1.f / 1024.f) + EPS) : 0.f; }
  f32x4 acc[4][4];
  gemm_tile<4>(acc, (const u16*)(ws + OFF_XB), 1024, base, lo, hi, (const u16*)(ws + OFF_WUP) + (size_t)ct * 128 * 1024, 1024, 1024, smem);
  acc_to_lds<4>(acc, Ct, rs);
  const float* wconv = p.in[20] + (size_t)l * 3 * DFF2; const float* bconv = p.in[21] + (size_t)l * DFF2;
  const float* cstate = p.in[7] + (size_t)l * 8 * 2 * DFF2;
  u16* act = (u16*)(ws + OFF_ACT);
#pragma unroll 1
  for (int i = 0; i < 16; ++i) {
    const int item = tid + NT * i; const int r = item >> 5, jp = item & 31;
    const int tok = base + r;
    bool valid; int bi = 0, ti = 2;
    if (sample) { valid = true; bi = (tok - TP) >> 6; ti = (tok - TP) & 63; }
    else valid = (r >= 2) && (tok < TP);
    if (!valid) continue;
    float cv[4];
#pragma unroll
    for (int q = 0; q < 2; ++q) {
#pragma unroll
      for (int ug = 0; ug < 2; ++ug) {
        const int jc = jp * 2 + q;
        const int lc = jc + ug * 64;
        const int oc = ug * DFF + ct * 64 + jc;
        const float u2 = Ct[r * CTS + lc];
        const float u1 = (ti >= 1) ? Ct[(r - 1) * CTS + lc] : cstate[((size_t)bi * 2 + 1) * DFF2 + oc];
        const float u0 = (ti >= 2) ? Ct[(r - 2) * CTS + lc] : cstate[((size_t)bi * 2 + ti) * DFF2 + oc];
        cv[q * 2 + ug] = bconv[oc] + wconv[oc] * u0 + wconv[DFF2 + oc] * u1 + wconv[2 * DFF2 + oc] * u2;
        if (!sample) { if (tok >= TP - 2) p.out[O_CVP + ((size_t)l * 2 + (tok - (TP - 2))) * DFF2 + oc] = u2; }
        else if (ti >= 62) p.out[O_CVS + (((size_t)l * 8 + bi) * 2 + (ti - 62)) * DFF2 + oc] = u2;
      }
    }
    *(unsigned*)(act + (size_t)tok * DFF + ct * 64 + jp * 2) = pack2(cv[0] * gelu_tanh(cv[1]), cv[2] * gelu_tanh(cv[3]));
  }
  __syncthreads();
}

DI void final_norm(const Params& p) {
  const int lane = tidx() & 63, wid = tidx() >> 6;
  const float* rowsq1 = (const float*)(p.ws + OFF_ROWSQ1);
  for (int it = blockIdx.x; it < T / 4; it += gridDim.x) {
    const int row = it * 4 + wid;
    const float rstd = rsqrtf(rowsq1[row] * (1.f / 1024.f) + EPS);
#pragma unroll
    for (int i = 0; i < 4; ++i) {
      const int c = (i * 64 + lane) * 4;
      float4 v = *(float4*)(p.out + (size_t)row * 1024 + c);
      const float4 g = *(const float4*)(p.in[23] + c);
      v.x *= rstd * g.x; v.y *= rstd * g.y; v.z *= rstd * g.z; v.w *= rstd * g.w;
      *(float4*)(p.out + (size_t)row * 1024 + c) = v;
    }
  }
}

__global__ void __launch_bounds__(NT, 2) fwd_megakernel(Params p) {
  extern __shared__ __attribute__((aligned(16))) char smem[];
  cg::grid_group grid = cg::this_grid();
#if USE_CG_SYNC
#define GSYNC() grid.sync()
#else
  __shared__ uint4 xb_words;
  if (threadIdx.x == 0) xb_words = make_uint4(0u, 0u, 0u, 0u);
  __syncthreads();
  XcdBarrier xb = xcd_barrier_post((unsigned*)(p.ws + OFF_BAR), (volatile LAS unsigned*)&xb_words);
  grid.sync();
#define GSYNC() xcd_barrier(xb)
#endif
  const int G = gridDim.x, bid = blockIdx.x;
  unsigned char* ws = p.ws;
  if (PHM & 1) phase0(p, smem);
  GSYNC();
  for (int l = 0; l < 2; ++l) {
    if (PHM & 2) cache_to_kv(p, l);
    if (PHM & 2) for (int it = bid; it < 132 * 34; it += G) p1_tile(p, l, it % 132, it / 132, smem);
    { float* rq2 = (float*)(ws + OFF_ROWSQ2); for (int i = bid * NT + threadIdx.x; i < T; i += G * NT) rq2[i] = 0.f; }
    GSYNC();
    for (int it = bid; it < 264 * 8 + 512 + 264 * 8; it += G) {
      if (it < 2112) { if (PHM & 4) attn_item<3, true>(p, l, it >> 3, it & 7, smem); }
      else if (it < 2624) { const int j = it - 2112; if (PHM & 8) hgrn_item<false>(p, l, j >> 2, j & 3, smem); }
      else { const int j = it - 2624; if (PHM & 16) attn_item<1, false>(p, l, j >> 3, j & 7, smem); }
    }
    GSYNC();
    if (PHM & 32) hgrn_scan(p, l);
    GSYNC();
    if (PHM & 64) for (int it = bid; it < 136 * 4; it += G) hgrn_item<true>(p, l, it >> 2, it & 3, smem);
    GSYNC();
    if (PHM & 128) for (int it = bid; it < NCONV_FFN; it += G) conv_wffn_item(p, l, it, smem);
    if (PHM & 256) for (int it = bid; it < 132 * 16; it += G) p5_tile(p, l, it % 132, it / 132, smem);
    GSYNC();
    { float* rq1 = (float*)(ws + OFF_ROWSQ1); for (int i = bid * NT + threadIdx.x; i < T; i += G * NT) rq1[i] = 0.f; }
    if (PHM & 512) for (int it = bid; it < 132 * 8; it += G)
      resid_tile(p, (const u16*)(ws + OFF_MIX), 1024, (const u16*)(ws + OFF_WOUT), 1024, (float*)(ws + OFF_ROWSQ2), it % 132, it / 132, smem);
    GSYNC();
    if (PHM & 1024) for (int it = bid; it < 135 * 44; it += G) p7_tile(p, l, it % 135, it / 135, smem);
    GSYNC();
    if (l == 0) for (int it = bid; it < NCONV_MIX; it += G) conv_wmix_item(p, 1, it, smem);
    if (PHM & 2048) for (int it = bid; it < 132 * 8; it += G)
      resid_tile(p, (const u16*)(ws + OFF_ACT), DFF, (const u16*)(ws + OFF_WDOWN), DFF, (float*)(ws + OFF_ROWSQ1), it % 132, it / 132, smem);
    GSYNC();
  }
  final_norm(p);
}

extern "C" void kernel_launch(void* const* d_in, const int* in_sizes, int n_in, void* d_out, int out_size,
                              void* d_ws, size_t ws_size, hipStream_t stream) {
  static int grid_blocks = 0;
  if (!grid_blocks) {
    int dev = 0, cus = 0, per_cu = 0;
    hipGetDevice(&dev);
    hipDeviceGetAttribute(&cus, hipDeviceAttributeMultiprocessorCount, dev);
    hipFuncSetAttribute((const void*)fwd_megakernel, hipFuncAttributeMaxDynamicSharedMemorySize, LDS_BYTES);
    hipOccupancyMaxActiveBlocksPerMultiprocessor(&per_cu, (const void*)fwd_megakernel, NT, LDS_BYTES);
    if (per_cu < 1) per_cu = 1;
    if (per_cu > 2) per_cu = 2;
    grid_blocks = cus * per_cu;
    if (ws_size < WS_END || (size_t)out_size < O_END || n_in < 24)
      fprintf(stderr, "kernel_launch: unexpected sizes ws=%zu need=%zu out=%d need=%zu n_in=%d\n", ws_size, (size_t)WS_END, out_size, (size_t)O_END, n_in);
  }
  Params p{};
  for (int i = 0; i < 24; ++i) p.in[i] = (const float*)d_in[i];
  p.out = (float*)d_out; p.ws = (unsigned char*)d_ws;
  hipMemsetAsync((char*)d_ws + OFF_BAR, 0, 16384, stream);
  void* args[] = {&p};
  hipError_t e = hipLaunchCooperativeKernel((const void*)fwd_megakernel, dim3(grid_blocks), dim3(NT), args, LDS_BYTES, stream);
  if (e != hipSuccess) fprintf(stderr, "cooperative launch failed: %s (grid %d)\n", hipGetErrorString(e), grid_blocks);
}
```

```cpp
#include <hip/hip_runtime.h>
#include <hip/hip_cooperative_groups.h>
#include <cstdio>
namespace cg = cooperative_groups;

typedef unsigned short u16;
using bf16x8 = __attribute__((ext_vector_type(8))) short;
using f32x4 = __attribute__((ext_vector_type(4))) float;
#define DI __device__ __forceinline__
#define MFMA16(a, b, c) __builtin_amdgcn_mfma_f32_16x16x32_bf16((a), (b), (c), 0, 0, 0)

#ifndef PHM
#define PHM 0xFFFF
#endif
#ifndef DBL
#define DBL 0
#endif
#ifndef USE_CG_SYNC
#define USE_CG_SYNC 0
#endif

constexpr int DM = 1024, TP = 16384, TS = 512, T = TP + TS, NBATCH = 8;
constexpr int INW = 7424, NIN1 = 4352;
constexpr int DFF = 2816, DFF2 = 5632;
constexpr int KA_ROWS = TP + NBATCH * 192, KB_ROWS = TP + NBATCH * 576;
constexpr int NT = 256;
constexpr float EPS = 1e-6f;
constexpr int LDS_BYTES = 73728 + 1024;

constexpr size_t OFF_BAR   = 0;
constexpr size_t OFF_ROWSQ1 = 16384;
constexpr size_t OFF_ROWSQ2 = OFF_ROWSQ1 + 67584;
constexpr size_t OFF_DECAY = OFF_ROWSQ2 + 67584;
constexpr size_t OFF_WMIX  = OFF_DECAY + 262144;
constexpr size_t W_IN_B = (size_t)INW * 1024 * 2, W_BR_B = (size_t)1024 * 512 * 2, W_OUT_B = (size_t)1024 * 1024 * 2;
constexpr size_t OFF_WIN = OFF_WMIX, OFF_WA = OFF_WIN + W_IN_B, OFF_WB = OFF_WA + W_BR_B, OFF_WC = OFF_WB + W_BR_B, OFF_WOUT = OFF_WC + W_BR_B;
constexpr size_t OFF_XB    = OFF_WOUT + W_OUT_B;
constexpr size_t OFF_ST    = OFF_XB + (size_t)T * 1024 * 2;
constexpr size_t OFF_WUP = OFF_ST, OFF_WDOWN = OFF_ST + (size_t)DFF2 * 1024 * 2;
constexpr size_t OFF_QA    = OFF_ST + (size_t)128 * 4 * 16384 * 4;
constexpr size_t PLANE = (size_t)T * 512 * 2;
constexpr size_t OFF_QB    = OFF_QA + PLANE;
constexpr size_t OFF_KA    = OFF_QB + PLANE;
constexpr size_t OFF_VTA   = OFF_KA + (size_t)KA_ROWS * 128 * 2;
constexpr size_t OFF_KB    = OFF_VTA + (size_t)KA_ROWS * 128 * 2;
constexpr size_t OFF_VTB   = OFF_KB + (size_t)KB_ROWS * 512 * 2;
constexpr size_t OFF_HF    = OFF_VTB + (size_t)KB_ROWS * 512 * 2;
constexpr size_t OFF_HI = OFF_HF + PLANE, OFF_HQ = OFF_HI + PLANE, OFF_HOG = OFF_HQ + PLANE;
constexpr size_t WS_END = OFF_HOG + PLANE;
constexpr size_t OFF_MIX = OFF_HF;
constexpr size_t OFF_ACT = OFF_QA;
static_assert(OFF_ACT + (size_t)T * DFF * 2 <= WS_END, "act fits");

constexpr size_t O_X = 0;
constexpr size_t O_AKP = (size_t)T * 1024;
constexpr size_t O_AVP = O_AKP + 32768;
constexpr size_t O_BKP = O_AVP + 32768;
constexpr size_t O_BVP = O_BKP + 524288;
constexpr size_t O_CP  = O_BVP + 524288;
constexpr size_t O_CVP = O_CP + 131072;
constexpr size_t O_AKS = O_CVP + 22528;
constexpr size_t O_AVS = O_AKS + 262144;
constexpr size_t O_BKS = O_AVS + 262144;
constexpr size_t O_BVS = O_BKS + 4194304;
constexpr size_t O_CS  = O_BVS + 4194304;
constexpr size_t O_CVS = O_CS + 1048576;
constexpr size_t O_END = O_CVS + 180224;

struct Params { const float* in[24]; float* out; unsigned char* ws; };

DI u16 f2bf(float x) { unsigned u = __float_as_uint(x); u += 0x7fffu + ((u >> 16) & 1u); return (u16)(u >> 16); }
DI float bf2f(u16 v) { return __uint_as_float(((unsigned)v) << 16); }
DI unsigned pack2(float a, float b) { return (unsigned)f2bf(a) | ((unsigned)f2bf(b) << 16); }
DI float lo_f(unsigned u) { return __uint_as_float(u << 16); }
DI float hi_f(unsigned u) { return __uint_as_float(u & 0xffff0000u); }
DI float wave_sum(float v) {
#pragma unroll
  for (int o = 32; o >= 1; o >>= 1) v += __shfl_xor(v, o, 64);
  return v;
}
DI int tidx() { int t = threadIdx.x; asm volatile("" : "+v"(t)); return t; }
DI float sigmoidf_(float x) { return 1.f / (1.f + __expf(-x)); }
DI int krowA(int tok) { if (tok < TP) return tok; int s = tok - TP; return TP + (s >> 6) * 192 + 128 + (s & 63); }
DI int krowB(int tok) { if (tok < TP) return tok; int s = tok - TP; return TP + (s >> 6) * 576 + 512 + (s & 63); }

#define XB_TMO      128
#define XB_XCNT(j)  (256  + 64 * (j))
#define XB_XSUB(j)  (1280 + 64 * (j))
#define XB_XGEN(j)  (2304 + 64 * (j))
#define XB_TOP      3328
#define XB_TOPGEN   3392
#define XCD_BAR_WORDS 3456
#define XB_SPIN_CAP (1u << 24)
#define LAS __attribute__((address_space(3)))
DI unsigned xb_ld(unsigned* p) { return __hip_atomic_load(p, __ATOMIC_RELAXED, __HIP_MEMORY_SCOPE_AGENT); }
DI unsigned xb_add(unsigned* p, unsigned v) { return __hip_atomic_fetch_add(p, v, __ATOMIC_RELAXED, __HIP_MEMORY_SCOPE_AGENT); }
DI unsigned xb_xcc_id() { return (unsigned)__builtin_amdgcn_s_getreg((3 << 11) | 20) & 0xFu; }
#define XB_SPIN(cond, bar) do { unsigned _sp = 0; while (cond) { __builtin_amdgcn_s_sleep(1); \
    if ((++_sp & 255u) == 0u) { if (xb_ld(&(bar)[XB_TMO])) break; if (_sp > XB_SPIN_CAP) { atomicAdd(&(bar)[XB_TMO], 1u); break; } } } } while (0)
struct XcdBarrier { unsigned* bar; unsigned x; volatile LAS unsigned* st; };
DI XcdBarrier xcd_barrier_post(unsigned* bar, volatile LAS unsigned* st) {
  XcdBarrier b; b.bar = bar; b.x = xb_xcc_id(); b.st = st;
  if (threadIdx.x == 0) (void)xb_add(&bar[XB_XCNT(b.x)], 1u);
  return b;
}
DI void xcd_barrier_complete(unsigned* bar, unsigned x, unsigned& nloc, unsigned& nx) {
  const unsigned G = gridDim.x;
  unsigned sum, cnt, mine, sp = 0u;
  for (;;) {
    sum = 0u; cnt = 0u; mine = 0u;
#pragma unroll
    for (unsigned j = 0; j < 16; ++j) { const unsigned c = xb_ld(&bar[XB_XCNT(j)]); sum += c; cnt += (c > 0u) ? 1u : 0u; mine = (j == x) ? c : mine; }
    if (sum == G) break;
    __builtin_amdgcn_s_sleep(1);
    if ((++sp & 255u) == 0u) { if (xb_ld(&bar[XB_TMO])) break; if (sp > XB_SPIN_CAP) { atomicAdd(&bar[XB_TMO], 1u); break; } }
  }
  nloc = mine > 0u ? mine : 1u; nx = cnt > 0u ? cnt : 1u;
}
DI void xcd_barrier(const XcdBarrier& b) {
  asm volatile("s_waitcnt vmcnt(0)" ::: "memory");
  __syncthreads();
  if (threadIdx.x == 0) {
    unsigned* bar = b.bar;
    __builtin_amdgcn_s_waitcnt(0);
    unsigned nloc = b.st[0], nx = b.st[1];
    if (nloc == 0u) { xcd_barrier_complete(bar, b.x, nloc, nx); b.st[0] = nloc; b.st[1] = nx; }
    const unsigned old = xb_add(&bar[XB_XSUB(b.x)], 1u);
    const unsigned gen = old / nloc;
    if (old + 1u == (gen + 1u) * nloc) {
      __builtin_amdgcn_fence(__ATOMIC_RELEASE, "agent");
      asm volatile("s_waitcnt vmcnt(0)" ::: "memory");
      const unsigned og = xb_add(&bar[XB_TOP], 1u);
      const unsigned tg = og / nx;
      if (og + 1u == (tg + 1u) * nx) xb_add(&bar[XB_TOPGEN], 1u);
      else XB_SPIN(xb_ld(&bar[XB_TOPGEN]) == tg, bar);
      __builtin_amdgcn_fence(__ATOMIC_ACQUIRE, "agent");
      xb_add(&bar[XB_XGEN(b.x)], 1u);
      asm volatile("s_waitcnt vmcnt(0)" ::: "memory");
    } else {
      XB_SPIN(xb_ld(&bar[XB_XGEN(b.x)]) == gen, bar);
      __builtin_amdgcn_fence(__ATOMIC_ACQUIRE, "agent");
      asm volatile("s_waitcnt vmcnt(0)" ::: "memory");
    }
  }
  __syncthreads();
}

template <int NB>
DI void gemm_tile(f32x4 (&acc)[4][NB], const u16* __restrict__ A, int lda, int row0, int lo, int hi,
                  const u16* __restrict__ W, int ldw, int K, char* smem) {
  const int tid = tidx(), lane = tid & 63, wid = tid >> 6, wr = wid >> 1, wc = wid & 1, fr = lane & 15, fq = lane >> 4;
  const int sr = tid >> 3, sc = tid & 7;
  uint4 ra0, ra1, ra2, ra3, rb0, rb1, rb2, rb3;
  rb0 = rb1 = rb2 = rb3 = make_uint4(0u, 0u, 0u, 0u);
#pragma unroll
  for (int m = 0; m < 4; ++m)
#pragma unroll
    for (int n = 0; n < NB; ++n) acc[m][n] = f32x4{0.f, 0.f, 0.f, 0.f};
  const int g0 = row0 + sr;
  const unsigned ma0 = (g0 >= lo && g0 < hi) ? 0xffffffffu : 0u, ma1 = (g0 + 32 >= lo && g0 + 32 < hi) ? 0xffffffffu : 0u;
  const unsigned ma2 = (g0 + 64 >= lo && g0 + 64 < hi) ? 0xffffffffu : 0u, ma3 = (g0 + 96 >= lo && g0 + 96 < hi) ? 0xffffffffu : 0u;
  const int c0r = min(max(g0, lo), hi - 1), c1r = min(max(g0 + 32, lo), hi - 1), c2r = min(max(g0 + 64, lo), hi - 1), c3r = min(max(g0 + 96, lo), hi - 1);
  const u16* ap0 = A + (size_t)c0r * lda + sc * 8;
  const u16* ap1 = A + (size_t)c1r * lda + sc * 8;
  const u16* ap2 = A + (size_t)c2r * lda + sc * 8;
  const u16* ap3 = A + (size_t)c3r * lda + sc * 8;
  const u16* wp = W + (size_t)sr * ldw + sc * 8;
  const size_t ws32 = (size_t)32 * ldw;
  int koff = 0;
  char* sw = smem + sr * 144 + sc * 16;
#define MSK(r, m) do { r.x &= m; r.y &= m; r.z &= m; r.w &= m; } while (0)
#define GLOAD() do { \
    ra0 = *(const uint4*)(ap0 + koff); ra1 = *(const uint4*)(ap1 + koff); ra2 = *(const uint4*)(ap2 + koff); ra3 = *(const uint4*)(ap3 + koff); \
    MSK(ra0, ma0); MSK(ra1, ma1); MSK(ra2, ma2); MSK(ra3, ma3); \
    rb0 = *(const uint4*)(wp + koff); rb1 = *(const uint4*)(wp + ws32 + koff); \
    if (NB > 2) { rb2 = *(const uint4*)(wp + 2 * ws32 + koff); rb3 = *(const uint4*)(wp + 3 * ws32 + koff); } \
    koff += 64; } while (0)
#define SWRITE(buf) do { char* b_ = sw + (buf) * 36864; \
    *(uint4*)(b_) = ra0; *(uint4*)(b_ + 32 * 144) = ra1; *(uint4*)(b_ + 64 * 144) = ra2; *(uint4*)(b_ + 96 * 144) = ra3; \
    *(uint4*)(b_ + 18432) = rb0; *(uint4*)(b_ + 18432 + 32 * 144) = rb1; \
    if (NB > 2) { *(uint4*)(b_ + 18432 + 64 * 144) = rb2; *(uint4*)(b_ + 18432 + 96 * 144) = rb3; } } while (0)
  GLOAD(); SWRITE(0); __syncthreads();
  const int nk = K >> 6;
#pragma unroll 1
  for (int kt = 0; kt < nk; ++kt) {
    if (kt + 1 < nk) GLOAD();
    const char* b = smem + (kt & 1) * 36864;
#pragma unroll
    for (int kk = 0; kk < 2; ++kk) {
      bf16x8 af[4], bfr[NB];
#pragma unroll
      for (int m = 0; m < 4; ++m) af[m] = *(const bf16x8*)(b + (wr * 64 + m * 16 + fr) * 144 + (kk * 32 + fq * 8) * 2);
#pragma unroll
      for (int n = 0; n < NB; ++n) bfr[n] = *(const bf16x8*)(b + 18432 + (wc * (NB * 16) + n * 16 + fr) * 144 + (kk * 32 + fq * 8) * 2);
#pragma unroll
      for (int m = 0; m < 4; ++m)
#pragma unroll
        for (int n = 0; n < NB; ++n) acc[m][n] = MFMA16(af[m], bfr[n], acc[m][n]);
    }
    if (kt + 1 < nk) SWRITE((kt + 1) & 1);
    __syncthreads();
  }
#undef GLOAD
#undef SWRITE
#undef MSK
}

constexpr int CTS = 132;
template <int NB>
DI void acc_to_lds(const f32x4 (&acc)[4][NB], float* Ct, const float* rs) {
  const int tid = tidx(), lane = tid & 63, wid = tid >> 6, wr = wid >> 1, wc = wid & 1, fr = lane & 15, fq = lane >> 4;
#pragma unroll
  for (int m = 0; m < 4; ++m)
#pragma unroll
    for (int j = 0; j < 4; ++j) {
      const int r = wr * 64 + m * 16 + fq * 4 + j;
      const float s = rs ? rs[r] : 1.f;
#pragma unroll
      for (int n = 0; n < NB; ++n) Ct[r * CTS + wc * (NB * 16) + n * 16 + fr] = acc[m][n][j] * s;
    }
  __syncthreads();
}

DI void conv_wtile(const float* __restrict__ src, int K, int N, u16* __restrict__ dst, const float* __restrict__ gain, int permute, int tile, float* tl) {
  const int tid = tidx();
  const int nnt = N >> 6; const int kt = tile / nnt, nt = tile - kt * nnt; const int k0 = kt * 64, n0 = nt * 64;
  {
    const int n = tid & 63, kq = tid >> 6;
#pragma unroll 4
    for (int i = 0; i < 16; ++i) { const int k = i * 4 + kq; float v = src[(size_t)(k0 + k) * N + n0 + n]; if (gain) v *= gain[k0 + k]; tl[k * 65 + n] = v; }
  }
  __syncthreads();
#pragma unroll
  for (int j = 0; j < 2; ++j) {
    const int n = (tid >> 3) + 32 * j, ks = tid & 7;
    float v[8];
#pragma unroll
    for (int q = 0; q < 8; ++q) v[q] = tl[(ks * 8 + q) * 65 + n];
    int nn = n0 + n;
    if (permute) nn = (nn < DFF) ? ((nn >> 6) * 128 + (nn & 63)) : ((((nn - DFF) >> 6) * 128) + 64 + ((nn - DFF) & 63));
    uint4 pk = make_uint4(pack2(v[0], v[1]), pack2(v[2], v[3]), pack2(v[4], v[5]), pack2(v[6], v[7]));
    *(uint4*)(dst + (size_t)nn * K + k0 + ks * 8) = pk;
  }
  __syncthreads();
}
constexpr int NCONV_MIX = 1856 + 3 * 128 + 256;
constexpr int NCONV_FFN = 1408 + 704;
DI void conv_wmix_item(const Params& p, int l, int it, char* smem) {
  float* tl = (float*)smem; unsigned char* ws = p.ws;
  if (it < 1856) conv_wtile(p.in[9] + (size_t)l * 1024 * INW, 1024, INW, (u16*)(ws + OFF_WIN), p.in[8] + l * 1024, 0, it, tl);
  else if (it < 1856 + 384) { const int b = (it - 1856) >> 7, t = (it - 1856) & 127;
    conv_wtile(p.in[14 + b] + (size_t)l * 512 * 1024, 512, 1024, (u16*)(ws + OFF_WA + b * W_BR_B), nullptr, 0, t, tl); }
  else conv_wtile(p.in[17] + (size_t)l * 1024 * 1024, 1024, 1024, (u16*)(ws + OFF_WOUT), nullptr, 0, it - 2240, tl);
}
DI void conv_wffn_item(const Params& p, int l, int it, char* smem) {
  float* tl = (float*)smem; unsigned char* ws = p.ws;
  if (it < 1408) conv_wtile(p.in[19] + (size_t)l * 1024 * DFF2, 1024, DFF2, (u16*)(ws + OFF_WUP), p.in[18] + l * 1024, 1, it, tl);
  else conv_wtile(p.in[22] + (size_t)l * DFF * 1024, DFF, 1024, (u16*)(ws + OFF_WDOWN), nullptr, 0, it - 1408, tl);
}

DI void phase0(const Params& p, char* smem) {
  const int tid = tidx(), lane = tid & 63, wid = tid >> 6;
  float* x = p.out; u16* xb = (u16*)(p.ws + OFF_XB);
  float* rowsq1 = (float*)(p.ws + OFF_ROWSQ1); float* rowsq2 = (float*)(p.ws + OFF_ROWSQ2);
  for (int it = blockIdx.x; it < T / 4; it += gridDim.x) {
    const int row = it * 4 + wid;
    const float* src = row < TP ? p.in[0] + (size_t)row * 1024 : p.in[1] + (size_t)(row - TP) * 1024;
    float ss = 0.f;
#pragma unroll
    for (int i = 0; i < 4; ++i) {
      const int c = (i * 64 + lane) * 4;
      const float4 v = *(const float4*)(src + c);
      *(float4*)(x + (size_t)row * 1024 + c) = v;
      ss += v.x * v.x + v.y * v.y + v.z * v.z + v.w * v.w;
      *(uint2*)(xb + (size_t)row * 1024 + c) = make_uint2(pack2(v.x, v.y), pack2(v.z, v.w));
    }
    ss = wave_sum(ss);
    if (lane == 0) { rowsq1[row] = ss; rowsq2[row] = 0.f; }
  }
  for (int it = blockIdx.x; it < NCONV_MIX; it += gridDim.x) conv_wmix_item(p, 0, it, smem);
  const size_t gsz = (size_t)gridDim.x * NT, g0 = (size_t)blockIdx.x * NT + tid;
  for (size_t e = g0; e < (size_t)2 * 8 * 64 * 128; e += gsz) {
    const size_t lb = e / (64 * 128), r = e % (64 * 128);
    p.out[O_AKS + lb * 128 * 128 + r] = p.in[2][lb * 128 * 128 + 64 * 128 + r];
    p.out[O_AVS + lb * 128 * 128 + r] = p.in[3][lb * 128 * 128 + 64 * 128 + r];
  }
  for (size_t e = g0; e < (size_t)2 * 8 * 448 * 512 / 4; e += gsz) {
    const size_t e4 = e * 4; const size_t lb = e4 / (448 * 512), r = e4 % (448 * 512);
    *(float4*)(p.out + O_BKS + lb * 512 * 512 + r) = *(const float4*)(p.in[4] + lb * 512 * 512 + 64 * 512 + r);
    *(float4*)(p.out + O_BVS + lb * 512 * 512 + r) = *(const float4*)(p.in[5] + lb * 512 * 512 + 64 * 512 + r);
  }
}

DI void cache_to_kv(const Params& p, int l) {
  const int tid = tidx();
  const size_t gsz = (size_t)gridDim.x * NT, g0 = (size_t)blockIdx.x * NT + tid;
  u16* Ka = (u16*)(p.ws + OFF_KA); u16* Vta = (u16*)(p.ws + OFF_VTA); u16* Kb = (u16*)(p.ws + OFF_KB); u16* Vtb = (u16*)(p.ws + OFF_VTB);
  for (size_t e = g0; e < (size_t)8 * 128 * 128 / 8; e += gsz) {
    const size_t e8 = e * 8; const int b = (int)(e8 / (128 * 128)); const int j = (int)((e8 / 128) % 128), c = (int)(e8 % 128);
    const float* s = p.in[2] + ((size_t)(l * 8 + b) * 128 + j) * 128 + c;
    const float4 v0 = *(const float4*)s, v1 = *(const float4*)(s + 4);
    *(uint4*)(Ka + (size_t)(TP + b * 192 + j) * 128 + c) = make_uint4(pack2(v0.x, v0.y), pack2(v0.z, v0.w), pack2(v1.x, v1.y), pack2(v1.z, v1.w));
  }
  for (size_t e = g0; e < (size_t)8 * 512 * 512 / 8; e += gsz) {
    const size_t e8 = e * 8; const int b = (int)(e8 / (512 * 512)); const int j = (int)((e8 / 512) % 512), c = (int)(e8 % 512);
    const float* s = p.in[4] + ((size_t)(l * 8 + b) * 512 + j) * 512 + c;
    const float4 v0 = *(const float4*)s, v1 = *(const float4*)(s + 4);
    *(uint4*)(Kb + (size_t)(TP + b * 576 + j) * 512 + c) = make_uint4(pack2(v0.x, v0.y), pack2(v0.z, v0.w), pack2(v1.x, v1.y), pack2(v1.z, v1.w));
  }
  for (size_t e = g0; e < (size_t)8 * 16 * 128; e += gsz) {
    const int c = (int)(e % 128), j8 = (int)((e / 128) % 16), b = (int)(e / (128 * 16));
    const float* s = p.in[3] + ((size_t)(l * 8 + b) * 128 + j8 * 8) * 128 + c;
    float v[8];
#pragma unroll
    for (int q = 0; q < 8; ++q) v[q] = s[(size_t)q * 128];
    *(uint4*)(Vta + (size_t)c * KA_ROWS + TP + b * 192 + j8 * 8) = make_uint4(pack2(v[0], v[1]), pack2(v[2], v[3]), pack2(v[4], v[5]), pack2(v[6], v[7]));
  }
  for (size_t e = g0; e < (size_t)8 * 64 * 512; e += gsz) {
    const int c = (int)(e % 512), j8 = (int)((e / 512) % 64), b = (int)(e / (512 * 64));
    const float* s = p.in[5] + ((size_t)(l * 8 + b) * 512 + j8 * 8) * 512 + c;
    float v[8];
#pragma unroll
    for (int q = 0; q < 8; ++q) v[q] = s[(size_t)q * 512];
    *(uint4*)(Vtb + (size_t)c * KB_ROWS + TP + b * 576 + j8 * 8) = make_uint4(pack2(v[0], v[1]), pack2(v[2], v[3]), pack2(v[4], v[5]), pack2(v[6], v[7]));
  }
}

DI void p1_tile(const Params& p, int l, int rt, int ct, char* smem) {
  const int tid = tidx();
  unsigned char* ws = p.ws;
  float* Ct = (float*)smem; float* rs = (float*)(smem + 73728);
  const float* rowsq1 = (const float*)(ws + OFF_ROWSQ1);
  const int row0 = rt * 128;
  if (tid < 128) rs[tid] = rsqrtf(rowsq1[row0 + tid] * (1.f / 1024.f) + EPS);
  f32x4 acc[4][4];
  gemm_tile<4>(acc, (const u16*)(ws + OFF_XB), 1024, row0, 0, T, (const u16*)(ws + OFF_WIN) + (size_t)ct * 128 * 1024, 1024, 1024, smem);
  acc_to_lds<4>(acc, Ct, rs);
  int kind, cb;
  u16* dst; int dstw;
  bool isB = false; int hplane = 0;
  if (ct < 4)       { kind = 0; cb = ct * 128;        dst = (u16*)(ws + OFF_QA); dstw = 512; }
  else if (ct == 4) { kind = 1; cb = 0;               dst = (u16*)(ws + OFF_KA); dstw = 128; }
  else if (ct == 5) { kind = 2; cb = 0;               dst = (u16*)(ws + OFF_VTA); dstw = 128; }
  else if (ct < 10) { kind = 3; cb = (ct - 6) * 128;  dst = (u16*)(ws + OFF_QB); dstw = 512; isB = true; }
  else if (ct < 14) { kind = 4; cb = (ct - 10) * 128; dst = (u16*)(ws + OFF_KB); dstw = 512; isB = true; }
  else if (ct < 18) { kind = 2; cb = (ct - 14) * 128; dst = (u16*)(ws + OFF_VTB); dstw = 512; isB = true; }
  else { kind = 3; hplane = (ct - 18) >> 2; cb = ((ct - 18) & 3) * 128; dst = (u16*)(ws + OFF_HF + (size_t)hplane * PLANE); dstw = 512; }
  const bool rope = (kind == 0 || kind == 1);
  const bool iskv = (kind == 1 || kind == 2 || kind == 4);
  const int R = isB ? 512 : 128;
  float* cache_p = nullptr; float* cache_s = nullptr;
  if (iskv) {
    const bool isv = (kind == 2);
    cache_p = p.out + (isB ? (isv ? O_BVP : O_BKP) : (isv ? O_AVP : O_AKP)) + (size_t)l * R * dstw;
    cache_s = p.out + (isB ? (isv ? O_BVS : O_BKS) : (isv ? O_AVS : O_AKS)) + (size_t)l * 8 * R * dstw;
  }
#pragma unroll 1
  for (int i = 0; i < 4; ++i) {
    const int item = tid + NT * i; const int r = item >> 3, g = item & 7;
    const int tok = row0 + r;
    float v[16];
#pragma unroll
    for (int q = 0; q < 4; ++q) { const float4 t4 = *(const float4*)(Ct + r * CTS + g * 16 + q * 4); v[q * 4] = t4.x; v[q * 4 + 1] = t4.y; v[q * 4 + 2] = t4.z; v[q * 4 + 3] = t4.w; }
    if (rope && (g & 3) == 0) {
      const float pos = (float)(tok < TP ? tok : 1024 + ((tok - TP) & 63));
#pragma unroll
      for (int d = 0; d < 8; ++d) {
        const float invf = exp2f(-(float)d * (18.931568569324174f / 8.f));
        float sn, cs; sincosf(pos * invf, &sn, &cs);
        const float x1 = v[d], x2 = v[d + 8];
        v[d] = x1 * cs - x2 * sn; v[d + 8] = x2 * cs + x1 * sn;
      }
    }
    const int col = cb + g * 16;
    if (kind != 2) {
      size_t drow;
      if (kind == 1) drow = (size_t)krowA(tok); else if (kind == 4) drow = (size_t)krowB(tok); else drow = (size_t)tok;
      u16* d = dst + drow * dstw + col;
      *(uint4*)d = make_uint4(pack2(v[0], v[1]), pack2(v[2], v[3]), pack2(v[4], v[5]), pack2(v[6], v[7]));
      *(uint4*)(d + 8) = make_uint4(pack2(v[8], v[9]), pack2(v[10], v[11]), pack2(v[12], v[13]), pack2(v[14], v[15]));
    }
    if (iskv) {
      float* cd = nullptr;
      if (tok < TP) { if (tok >= TP - R) cd = cache_p + (size_t)(tok - (TP - R)) * dstw + col; }
      else { const int s = tok - TP; cd = cache_s + ((size_t)(s >> 6) * R + (R - 64) + (s & 63)) * dstw + col; }
      if (cd) {
#pragma unroll
        for (int q = 0; q < 4; ++q) *(float4*)(cd + q * 4) = make_float4(v[q * 4], v[q * 4 + 1], v[q * 4 + 2], v[q * 4 + 3]);
      }
    }
  }
  if (kind == 2) {
    const int ROWS = isB ? KB_ROWS : KA_ROWS;
#pragma unroll 1
    for (int i = 0; i < 8; ++i) {
      const int item = tid + NT * i; const int g8 = item & 15, c = item >> 4;
      float v[8];
#pragma unroll
      for (int q = 0; q < 8; ++q) v[q] = Ct[(g8 * 8 + q) * CTS + c];
      const int tok = row0 + g8 * 8;
      const int kr = isB ? krowB(tok) : krowA(tok);
      *(uint4*)(dst + (size_t)(cb + c) * ROWS + kr) = make_uint4(pack2(v[0], v[1]), pack2(v[2], v[3]), pack2(v[4], v[5]), pack2(v[6], v[7]));
    }
  }
  __syncthreads();
}

constexpr int AT_KS = 2048;
constexpr int AT_VS = AT_KS + 192 * 144;
template <bool ISB>
DI void attn_item(const Params& p, int l, int sc, int hh, char* smem) {
  constexpr int NG = ISB ? 3 : 1, NQH = ISB ? 1 : 4;
  const int tid = tidx(), lane = tid & 63, wid = tid >> 6, fr = lane & 15, fq = lane >> 4;
  constexpr int KW = ISB ? 512 : 128;
  constexpr int KROWS = ISB ? KB_ROWS : KA_ROWS;
  constexpr int R = ISB ? 512 : 128;
  u16* Q = (u16*)(p.ws + (ISB ? OFF_QB : OFF_QA));
  const u16* Kp = (const u16*)(p.ws + (ISB ? OFF_KB : OFF_KA));
  const u16* Vt = (const u16*)(p.ws + (ISB ? OFF_VTB : OFF_VTA));
  int tokq0, kband0, firstblk;
  if (sc < 256) { tokq0 = sc * 64; kband0 = sc * 64 - R; firstblk = kband0 < 0 ? ((-kband0) >> 4) : 0; }
  else { const int b = sc - 256; tokq0 = TP + b * 64; kband0 = TP + b * (R + 64); firstblk = 0; }
  const int hk = hh;
  const int qrow = tokq0 + wid * 16 + fr;
  const float* table = (const float*)smem;
  float tconst = 0.f;
  __syncthreads();
  if (ISB) {
    const float* gt = p.in[11] + (size_t)(l * 8 + hh) * 257;
    float* tw = (float*)smem;
    tw[tid] = gt[tid]; if (tid < 64) tw[256 + tid] = gt[256];
  }
  const int qi = wid * 16 + fr;
  const float* eb = table + (65 + qi - fq * 4);
  float m_run = -1e30f, l_run = 0.f;
  f32x4 o[4];
#pragma unroll
  for (int d = 0; d < 4; ++d) o[d] = f32x4{0.f, 0.f, 0.f, 0.f};
  bf16x8 qf[2];
  if (NQH == 1) {
#pragma unroll
    for (int kk = 0; kk < 2; ++kk) qf[kk] = *(const bf16x8*)(Q + (size_t)qrow * 512 + hh * 64 + kk * 32 + fq * 8);
  }
#pragma unroll 1
  for (int g = 0; g < NG; ++g) {
    const int fb = firstblk - g * 12;
    if (fb >= 12) continue;
    const int kb0 = kband0 + g * 192;
    if (g > 0) __syncthreads();
#pragma unroll
    for (int i = 0; i < 6; ++i) {
      const int c = tid + NT * i;
      { const int row = c >> 3, ch = c & 7;
        if (row >= fb * 16) *(uint4*)(smem + AT_KS + row * 144 + ch * 16) = *(const uint4*)(Kp + (size_t)(kb0 + row) * KW + hk * 64 + ch * 8); }
      { const int row = c / 24, ch = c - row * 24;
        if (ch * 8 >= fb * 16) *(uint4*)(smem + AT_VS + row * 400 + ch * 16) = *(const uint4*)(Vt + (size_t)(hk * 64 + row) * KROWS + kb0 + ch * 8); }
    }
    __syncthreads();
    if (ISB && g == 0) tconst = table[256];
#pragma unroll 1
    for (int qh = 0; qh < NQH; ++qh) {
      const int h = ISB ? hh : hh * 4 + qh;
      if (NQH > 1) {
#pragma unroll
        for (int kk = 0; kk < 2; ++kk) qf[kk] = *(const bf16x8*)(Q + (size_t)qrow * 512 + h * 64 + kk * 32 + fq * 8);
        m_run = p.in[10][l * 8 + h]; l_run = 1.f;
#pragma unroll
        for (int d = 0; d < 4; ++d) o[d] = f32x4{0.f, 0.f, 0.f, 0.f};
      }
      f32x4 s[12];
#pragma unroll
      for (int blk = 0; blk < 12; ++blk) {
        f32x4 a = {0.f, 0.f, 0.f, 0.f};
        if ((blk & 3) == 0) asm volatile("" ::: "memory");
        if (blk >= fb) {
          const char* kr = smem + AT_KS + (blk * 16 + fr) * 144 + fq * 16;
          const bf16x8 k0 = *(const bf16x8*)kr, k1 = *(const bf16x8*)(kr + 64);
          a = MFMA16(k0, qf[0], a); a = MFMA16(k1, qf[1], a);
        }
        s[blk] = a;
      }
      float mx = -1e30f;
#pragma unroll
      for (int blk = 0; blk < 12; ++blk) {
#pragma unroll
        for (int j = 0; j < 4; ++j) {
          float v = s[blk][j] * 0.125f;
          if (ISB) {
            if (g < 2) v += tconst;
            else v += eb[191 - (blk * 16 + j)];
          }
          if (blk < fb) v = -1e30f;
          s[blk][j] = v; mx = fmaxf(mx, v);
        }
      }
      mx = fmaxf(mx, __shfl_xor(mx, 16, 64)); mx = fmaxf(mx, __shfl_xor(mx, 32, 64));
      const float m_new = fmaxf(m_run, mx);
      const float scale = __expf(m_run - m_new);
      m_run = m_new;
      float sum = 0.f;
#pragma unroll
      for (int blk = 0; blk < 12; ++blk)
#pragma unroll
        for (int j = 0; j < 4; ++j) { const float e = __expf(s[blk][j] - m_new); s[blk][j] = e; sum += e; }
      sum += __shfl_xor(sum, 16, 64); sum += __shfl_xor(sum, 32, 64);
      l_run = l_run * scale + sum;
#pragma unroll
      for (int d = 0; d < 4; ++d) { o[d][0] *= scale; o[d][1] *= scale; o[d][2] *= scale; o[d][3] *= scale; }
#pragma unroll
      for (int pp = 0; pp < 6; ++pp) {
        if ((pp & 1) == 0) asm volatile("" ::: "memory");
        if (2 * pp >= fb) {
          uint4 pk = make_uint4(pack2(s[2 * pp][0], s[2 * pp][1]), pack2(s[2 * pp][2], s[2 * pp][3]),
                                pack2(s[2 * pp + 1][0], s[2 * pp + 1][1]), pack2(s[2 * pp + 1][2], s[2 * pp + 1][3]));
          const bf16x8 pb = __builtin_bit_cast(bf16x8, pk);
#pragma unroll
          for (int d = 0; d < 4; ++d) {
            const char* vr = smem + AT_VS + (d * 16 + fr) * 400 + (pp * 32 + fq * 4) * 2;
            const uint2 lo = *(const uint2*)vr, hi = *(const uint2*)(vr + 32);
            const bf16x8 va = __builtin_bit_cast(bf16x8, make_uint4(lo.x, lo.y, hi.x, hi.y));
            o[d] = MFMA16(va, pb, o[d]);
          }
        }
      }
      if (NQH > 1) {
        const float inv = 1.f / l_run;
#pragma unroll
        for (int d = 0; d < 4; ++d)
          *(uint2*)(Q + (size_t)qrow * 512 + h * 64 + d * 16 + fq * 4) = make_uint2(pack2(o[d][0] * inv, o[d][1] * inv), pack2(o[d][2] * inv, o[d][3] * inv));
      }
    }
  }
  if (NQH == 1) {
    const float inv = 1.f / l_run;
#pragma unroll
    for (int d = 0; d < 4; ++d)
      *(uint2*)(Q + (size_t)qrow * 512 + hh * 64 + d * 16 + fq * 4) = make_uint2(pack2(o[d][0] * inv, o[d][1] * inv), pack2(o[d][2] * inv, o[d][3] * inv));
  }
}

constexpr int HS = 20;
template <bool OUT>
DI void hgrn_item(const Params& p, int l, int cidx, int h, char* smem) {
  const int tid = tidx(), v = tid & 127, half = tid >> 7;
  unsigned char* ws = p.ws;
  float* qdT = (float*)smem;
  float* kdT = qdT + 128 * HS;
  float* kpT = kdT + 128 * HS;
  float* vS = kpT + 128 * HS;
  float* ob0 = vS + 2048;
  float* AsT = ob0 + 4096;
  float* tot = AsT + 256;
  float* dec = tot + 256;
  const u16* Hf = (const u16*)(ws + OFF_HF); const u16* Hi = (const u16*)(ws + OFF_HI);
  u16* Hq = (u16*)(ws + OFF_HQ); const u16* Hog = (const u16*)(ws + OFF_HOG);
  const bool sample = OUT && cidx >= 128;
  const int tok_base = sample ? TP + (cidx - 128) * 64 : cidx * 128;
  const int nsb = sample ? 4 : 8;
  float lb = 0.f;
  { const int k = tid & 127; if (l == 1) lb = sigmoidf_(p.in[12][512 + h * 128 + k] - p.in[12][h * 128 + k]); }
  float S[64];
  if (OUT) {
    const float* s0 = sample ? p.in[6] + ((size_t)(l * 8 + (cidx - 128)) * 4 + h) * 16384
                             : (const float*)(ws + OFF_ST) + ((size_t)cidx * 4 + h) * 16384;
    const float* ps = s0 + (size_t)(half * 64) * 128 + v;
#pragma unroll
    for (int kk = 0; kk < 64; ++kk) {
      if ((kk & 7) == 0) asm volatile("" : "+v"(ps));
      S[kk] = ps[(kk & 7) * 128];
      if ((kk & 7) == 7) ps += 8 * 128;
    }
  } else {
#pragma unroll
    for (int kk = 0; kk < 64; ++kk) S[kk] = 0.f;
  }
  float lastsum = 0.f;
#pragma unroll 1
  for (int sb = 0; sb < nsb; ++sb) {
    const int tok0 = tok_base + sb * 16;
    __syncthreads();
    float lf[8], kk8[8], q8[8];
    {
      const int k = v;
      float run = 0.f;
#pragma unroll
      for (int i = 0; i < 8; ++i) {
        const size_t off = (size_t)(tok0 + half * 8 + i) * 512 + h * 128 + k;
        const float z = bf2f(Hf[off]);
        const float e = __expf(-fabsf(z));
        const float sp = 1.f / (1.f + e);
        const float sig = z >= 0.f ? sp : e * sp;
        const float nsig = z >= 0.f ? e * sp : sp;
        float lfi;
        if (lb > 0.f) lfi = __logf(lb + (1.f - lb) * sig);
        else lfi = fminf(z, 0.f) - log1pf(e);
        run += lfi; lf[i] = run;
        kk8[i] = (1.f - lb) * nsig;
        if (OUT) { const float qp = bf2f(Hq[off]); q8[i] = qp * sigmoidf_(qp); } else q8[i] = 0.f;
        vS[(half * 8 + i) * 128 + k] = bf2f(Hi[off]);
      }
      tot[half * 128 + k] = run;
    }
    __syncthreads();
    {
      const int k = v;
      const float t0 = tot[k], t1 = tot[128 + k];
      const float last = t0 + t1, base = half ? t0 : 0.f;
      float qd[8], kd[8], kp[8];
#pragma unroll
      for (int i = 0; i < 8; ++i) {
        const float cum = base + lf[i];
        qd[i] = q8[i] * __expf(cum);
        kd[i] = kk8[i] * __expf(last - cum);
        kp[i] = kk8[i] * __expf(fminf(-cum, 80.f));
      }
      float* d0 = kdT + k * HS + half * 8;
      *(float4*)d0 = make_float4(kd[0], kd[1], kd[2], kd[3]); *(float4*)(d0 + 4) = make_float4(kd[4], kd[5], kd[6], kd[7]);
      if (OUT) {
        float* d1 = qdT + k * HS + half * 8; float* d2 = kpT + k * HS + half * 8;
        *(float4*)d1 = make_float4(qd[0], qd[1], qd[2], qd[3]); *(float4*)(d1 + 4) = make_float4(qd[4], qd[5], qd[6], qd[7]);
        *(float4*)d2 = make_float4(kp[0], kp[1], kp[2], kp[3]); *(float4*)(d2 + 4) = make_float4(kp[4], kp[5], kp[6], kp[7]);
      }
      if (half == 0) dec[k] = __expf(last);
      lastsum += last;
    }
    __syncthreads();
    float vreg[16];
#pragma unroll
    for (int t = 0; t < 16; ++t) vreg[t] = vS[t * 128 + v];
    if (OUT) {
#ifndef HX3
      {
        const int t = tid >> 4, s = tid & 15;
        float a = 0.f;
#pragma unroll 8
        for (int k = 0; k < 128; ++k) a += qdT[k * HS + t] * kpT[k * HS + s];
        AsT[s * 16 + t] = (s <= t) ? a : 0.f;
      }
#endif
      float o[16];
#pragma unroll
      for (int t = 0; t < 16; ++t) o[t] = 0.f;
#ifndef HX4
#pragma unroll
      for (int kk = 0; kk < 64; ++kk) {
        asm volatile("" ::: "memory");
        const float* qr = qdT + (half * 64 + kk) * HS;
        const float sv = S[kk];
#pragma unroll
        for (int q = 0; q < 4; ++q) { const float4 t4 = *(const float4*)(qr + q * 4); o[q * 4] += sv * t4.x; o[q * 4 + 1] += sv * t4.y; o[q * 4 + 2] += sv * t4.z; o[q * 4 + 3] += sv * t4.w; }
      }
#endif
      __syncthreads();
#pragma unroll
      for (int si = 0; si < 8; ++si) {
        const int s = half * 8 + si;
        const float vs = vreg[s];
        const float* ar = AsT + s * 16;
#pragma unroll
        for (int q = 0; q < 4; ++q) { const float4 t4 = *(const float4*)(ar + q * 4); o[q * 4] += vs * t4.x; o[q * 4 + 1] += vs * t4.y; o[q * 4 + 2] += vs * t4.z; o[q * 4 + 3] += vs * t4.w; }
      }
      float* ob = ob0 + half * 2048;
#pragma unroll
      for (int t = 0; t < 16; ++t) ob[t * 128 + v] = o[t];
      __syncthreads();
#ifndef HX6
      {
        const int t = tid >> 4, seg = tid & 15;
        float ov[8];
        const float4 a0 = *(const float4*)(ob0 + t * 128 + seg * 8), a1 = *(const float4*)(ob0 + t * 128 + seg * 8 + 4);
        const float4 b0 = *(const float4*)(ob0 + 2048 + t * 128 + seg * 8), b1 = *(const float4*)(ob0 + 2048 + t * 128 + seg * 8 + 4);
        ov[0] = a0.x + b0.x; ov[1] = a0.y + b0.y; ov[2] = a0.z + b0.z; ov[3] = a0.w + b0.w;
        ov[4] = a1.x + b1.x; ov[5] = a1.y + b1.y; ov[6] = a1.z + b1.z; ov[7] = a1.w + b1.w;
        float ss = 0.f;
#pragma unroll
        for (int q = 0; q < 8; ++q) ss += ov[q] * ov[q];
        ss += __shfl_xor(ss, 1, 64); ss += __shfl_xor(ss, 2, 64); ss += __shfl_xor(ss, 4, 64); ss += __shfl_xor(ss, 8, 64);
        const float rn = rsqrtf(ss * (1.f / 128.f) + EPS);
        const size_t off = (size_t)(tok0 + t) * 512 + h * 128 + seg * 8;
        const uint4 ogp = *(const uint4*)(Hog + off);
        const unsigned ogw[4] = {ogp.x, ogp.y, ogp.z, ogp.w};
        const float* cn = p.in[13] + l * 512 + h * 128 + seg * 8;
        float r8[8];
#pragma unroll
        for (int q = 0; q < 8; ++q) {
          const float g = (q & 1) ? hi_f(ogw[q >> 1]) : lo_f(ogw[q >> 1]);
          r8[q] = ov[q] * rn * cn[q] * (g * sigmoidf_(g));
        }
        *(uint4*)(Hq + off) = make_uint4(pack2(r8[0], r8[1]), pack2(r8[2], r8[3]), pack2(r8[4], r8[5]), pack2(r8[6], r8[7]));
      }
#endif
    }
#ifndef HX7
#pragma unroll
    for (int kk = 0; kk < 64; ++kk) {
      asm volatile("" ::: "memory");
      const int k = half * 64 + kk;
      const float* kr = kdT + k * HS;
      float a = dec[k] * S[kk];
#pragma unroll
      for (int q = 0; q < 4; ++q) { const float4 t4 = *(const float4*)(kr + q * 4); a += t4.x * vreg[q * 4] + t4.y * vreg[q * 4 + 1] + t4.z * vreg[q * 4 + 2] + t4.w * vreg[q * 4 + 3]; }
      S[kk] = a;
    }
#endif
  }
  if (!OUT) {
    float* D = (float*)(ws + OFF_ST) + ((size_t)cidx * 4 + h) * 16384 + (size_t)(half * 64) * 128 + v;
#pragma unroll
    for (int kk = 0; kk < 64; ++kk) {
      if ((kk & 7) == 0) asm volatile("" : "+v"(D));
      D[(kk & 7) * 128] = S[kk];
      if ((kk & 7) == 7) D += 8 * 128;
    }
    if (half == 0) ((float*)(ws + OFF_DECAY))[((size_t)cidx * 4 + h) * 128 + v] = __expf(lastsum);
  } else if (sample) {
    float* D = p.out + O_CS + ((size_t)(l * 8 + (cidx - 128)) * 4 + h) * 16384 + (size_t)(half * 64) * 128 + v;
#pragma unroll
    for (int kk = 0; kk < 64; ++kk) {
      if ((kk & 7) == 0) asm volatile("" : "+v"(D));
      D[(kk & 7) * 128] = S[kk];
      if ((kk & 7) == 7) D += 8 * 128;
    }
  }
  __syncthreads();
}

DI void hgrn_scan(const Params& p, int l) {
  float* ST = (float*)(p.ws + OFF_ST); const float* DEC = (const float*)(p.ws + OFF_DECAY);
  for (int e = blockIdx.x * NT + tidx(); e < 65536; e += gridDim.x * NT) {
    const int h = e >> 14, k = (e >> 7) & 127;
    float S = 0.f;
    float* ptr = ST + (size_t)h * 16384 + (e & 16383);
    const float* dp = DEC + h * 128 + k;
#pragma unroll 1
    for (int c0 = 0; c0 < 128; c0 += 8) {
      float d[8], dc[8];
#pragma unroll
      for (int i = 0; i < 8; ++i) { d[i] = ptr[(size_t)(c0 + i) * 65536]; dc[i] = dp[(c0 + i) * 512]; }
#pragma unroll
      for (int i = 0; i < 8; ++i) { ptr[(size_t)(c0 + i) * 65536] = S; S = dc[i] * S + d[i]; }
    }
    p.out[O_CP + (size_t)l * 65536 + e] = S;
  }
}

DI void p5_tile(const Params& p, int l, int rt, int ct, char* smem) {
  const int tid = tidx(), lane = tid & 63, wid = tid >> 6, wr = wid >> 1, fq = lane >> 4;
  unsigned char* ws = p.ws;
  float* Ct = (float*)smem; float* rs = (float*)(smem + 73728);
  const float* rowsq1 = (const float*)(ws + OFF_ROWSQ1);
  const int row0 = rt * 128, c0 = ct * 64;
  __syncthreads();
  if (tid < 128) rs[tid] = rsqrtf(rowsq1[row0 + tid] * (1.f / 1024.f) + EPS);
  f32x4 mix[4][2];
#pragma unroll
  for (int m = 0; m < 4; ++m)
#pragma unroll
    for (int n = 0; n < 2; ++n) mix[m][n] = f32x4{0.f, 0.f, 0.f, 0.f};
#pragma unroll 1
  for (int br = 0; br < 3; ++br) {
    f32x4 acc[4][2];
    gemm_tile<2>(acc, (const u16*)(ws + OFF_XB), 1024, row0, 0, T, (const u16*)(ws + OFF_WIN) + (size_t)(NIN1 + br * 1024 + c0) * 1024, 1024, 1024, smem);
    uint2 sg[4][2];
#pragma unroll
    for (int m = 0; m < 4; ++m) {
      const float4 r4 = *(const float4*)(rs + wr * 64 + m * 16 + fq * 4);
#pragma unroll
      for (int n = 0; n < 2; ++n)
        sg[m][n] = make_uint2(pack2(sigmoidf_(acc[m][n][0] * r4.x), sigmoidf_(acc[m][n][1] * r4.y)),
                              pack2(sigmoidf_(acc[m][n][2] * r4.z), sigmoidf_(acc[m][n][3] * r4.w)));
    }
    const u16* Ob = (const u16*)(ws + (br == 0 ? OFF_QA : (br == 1 ? OFF_QB : OFF_HQ)));
    gemm_tile<2>(acc, Ob, 512, row0, 0, T, (const u16*)(ws + OFF_WA + br * W_BR_B) + (size_t)c0 * 512, 512, 512, smem);
#pragma unroll
    for (int m = 0; m < 4; ++m)
#pragma unroll
      for (int n = 0; n < 2; ++n)
      {
        mix[m][n][0] += lo_f(sg[m][n].x) * acc[m][n][0]; mix[m][n][1] += hi_f(sg[m][n].x) * acc[m][n][1];
        mix[m][n][2] += lo_f(sg[m][n].y) * acc[m][n][2]; mix[m][n][3] += hi_f(sg[m][n].y) * acc[m][n][3];
      }
  }
  acc_to_lds<2>(mix, Ct, nullptr);
  u16* mixb = (u16*)(ws + OFF_MIX);
#pragma unroll 1
  for (int i = 0; i < 2; ++i) {
    const int item = tid + NT * i; const int r = item >> 2, g = item & 3;
    float v[16];
#pragma unroll
    for (int q = 0; q < 4; ++q) { const float4 t4 = *(const float4*)(Ct + r * CTS + g * 16 + q * 4); v[q * 4] = t4.x; v[q * 4 + 1] = t4.y; v[q * 4 + 2] = t4.z; v[q * 4 + 3] = t4.w; }
    u16* d = mixb + (size_t)(row0 + r) * 1024 + c0 + g * 16;
    *(uint4*)d = make_uint4(pack2(v[0], v[1]), pack2(v[2], v[3]), pack2(v[4], v[5]), pack2(v[6], v[7]));
    *(uint4*)(d + 8) = make_uint4(pack2(v[8], v[9]), pack2(v[10], v[11]), pack2(v[12], v[13]), pack2(v[14], v[15]));
  }
  __syncthreads();
}

DI void resid_tile(const Params& p, const u16* A, int lda, const u16* W, int K, float* rowsq, int rt, int ct, char* smem) {
  const int tid = tidx();
  float* Ct = (float*)smem;
  const int row0 = rt * 128, c0 = ct * 128;
  f32x4 acc[4][4];
  gemm_tile<4>(acc, A, lda, row0, 0, T, W + (size_t)c0 * K, K, K, smem);
  acc_to_lds<4>(acc, Ct, nullptr);
  float* x = p.out; u16* xb = (u16*)(p.ws + OFF_XB);
#pragma unroll 1
  for (int i = 0; i < 4; ++i) {
    const int item = tid + NT * i; const int r = item >> 3, g = item & 7;
    float* xp = x + (size_t)(row0 + r) * 1024 + c0 + g * 16;
    float v[16]; float ss = 0.f;
#pragma unroll
    for (int q = 0; q < 4; ++q) {
      const float4 t4 = *(const float4*)(Ct + r * CTS + g * 16 + q * 4); float4 x4 = *(const float4*)(xp + q * 4);
      x4.x += t4.x; x4.y += t4.y; x4.z += t4.z; x4.w += t4.w;
      *(float4*)(xp + q * 4) = x4;
      v[q * 4] = x4.x; v[q * 4 + 1] = x4.y; v[q * 4 + 2] = x4.z; v[q * 4 + 3] = x4.w;
      ss += x4.x * x4.x + x4.y * x4.y + x4.z * x4.z + x4.w * x4.w;
    }
    u16* d = xb + (size_t)(row0 + r) * 1024 + c0 + g * 16;
    *(uint4*)d = make_uint4(pack2(v[0], v[1]), pack2(v[2], v[3]), pack2(v[4], v[5]), pack2(v[6], v[7]));
    *(uint4*)(d + 8) = make_uint4(pack2(v[8], v[9]), pack2(v[10], v[11]), pack2(v[12], v[13]), pack2(v[14], v[15]));
    ss += __shfl_xor(ss, 1, 64); ss += __shfl_xor(ss, 2, 64); ss += __shfl_xor(ss, 4, 64);
    if (g == 0) atomicAdd(rowsq + row0 + r, ss);
  }
  __syncthreads();
}

DI float gelu_tanh(float g) { const float u = 0.7978845608028654f * (g + 0.044715f * g * g * g); return 0.5f * g * (1.f + tanhf(u)); }
DI void p7_tile(const Params& p, int l, int rt, int ct, char* smem) {
  const int tid = tidx();
  unsigned char* ws = p.ws;
  float* Ct = (float*)smem; float* rs = (float*)(smem + 73728);
  const float* rowsq2 = (const float*)(ws + OFF_ROWSQ2);
  const bool sample = rt >= 131;
  const int base = sample ? TP + (rt - 131) * 128 : rt * 126 - 2;
  const int lo = sample ? TP : 0, hi = sample ? T : TP;
  __syncthreads();
  if (tid < 128) { const int g = base + tid; rs[tid] = (g >= lo && g < hi) ? rsqrtf(rowsq2[g] * (1.f / 1024.f) + EPS) : 0.f; }
  f32x4 acc[4][4];
  gemm_tile<4>(acc, (const u16*)(ws + OFF_XB), 1024, base, lo, hi, (const u16*)(ws + OFF_WUP) + (size_t)ct * 128 * 1024, 1024, 1024, smem);
  acc_to_lds<4>(acc, Ct, rs);
  const float* wconv = p.in[20] + (size_t)l * 3 * DFF2; const float* bconv = p.in[21] + (size_t)l * DFF2;
  const float* cstate = p.in[7] + (size_t)l * 8 * 2 * DFF2;
  u16* act = (u16*)(ws + OFF_ACT);
#pragma unroll 1
  for (int i = 0; i < 16; ++i) {
    const int item = tid + NT * i; const int r = item >> 5, jp = item & 31;
    const int tok = base + r;
    bool valid; int bi = 0, ti = 2;
    if (sample) { valid = true; bi = (tok - TP) >> 6; ti = (tok - TP) & 63; }
    else valid = (r >= 2) && (tok < TP);
    if (!valid) continue;
    float cv[4];
#pragma unroll
    for (int q = 0; q < 2; ++q) {
#pragma unroll
      for (int ug = 0; ug < 2; ++ug) {
        const int jc = jp * 2 + q;
        const int lc = jc + ug * 64;
        const int oc = ug * DFF + ct * 64 + jc;
        const float u2 = Ct[r * CTS + lc];
        const float u1 = (ti >= 1) ? Ct[(r - 1) * CTS + lc] : cstate[((size_t)bi * 2 + 1) * DFF2 + oc];
        const float u0 = (ti >= 2) ? Ct[(r - 2) * CTS + lc] : cstate[((size_t)bi * 2 + ti) * DFF2 + oc];
        cv[q * 2 + ug] = bconv[oc] + wconv[oc] * u0 + wconv[DFF2 + oc] * u1 + wconv[2 * DFF2 + oc] * u2;
        if (!sample) { if (tok >= TP - 2) p.out[O_CVP + ((size_t)l * 2 + (tok - (TP - 2))) * DFF2 + oc] = u2; }
        else if (ti >= 62) p.out[O_CVS + (((size_t)l * 8 + bi) * 2 + (ti - 62)) * DFF2 + oc] = u2;
      }
    }
    *(unsigned*)(act + (size_t)tok * DFF + ct * 64 + jp * 2) = pack2(cv[0] * gelu_tanh(cv[1]), cv[2] * gelu_tanh(cv[3]));
  }
  __syncthreads();
}

DI void final_norm(const Params& p) {
  const int lane = tidx() & 63, wid = tidx() >> 6;
  const float* rowsq1 = (const float*)(p.ws + OFF_ROWSQ1);
  for (int it = blockIdx.x; it < T / 4; it += gridDim.x) {
    const int row = it * 4 + wid;
    const float rstd = rsqrtf(rowsq1[row] * (1.f / 1024.f) + EPS);
#pragma unroll
    for (int i = 0; i < 4; ++i) {
      const int c = (i * 64 + lane) * 4;
      float4 v = *(float4*)(p.out + (size_t)row * 1024 + c);
      const float4 g = *(const float4*)(p.in[23] + c);
      v.x *= rstd * g.x; v.y *= rstd * g.y; v.z *= rstd * g.z; v.w *= rstd * g.w;
      *(float4*)(p.out + (size_t)row * 1024 + c) = v;
    }
  }
}

__global__ void __launch_bounds__(NT, 2) fwd_megakernel(Params p) {
  extern __shared__ __attribute__((aligned(16))) char smem[];
  cg::grid_group grid = cg::this_grid();
#if USE_CG_SYNC
#define GSYNC() grid.sync()
#else
  __shared__ uint4 xb_words;
  if (threadIdx.x == 0) xb_words = make_uint4(0u, 0u, 0u, 0u);
  __syncthreads();
  XcdBarrier xb = xcd_barrier_post((unsigned*)(p.ws + OFF_BAR), (volatile LAS unsigned*)&xb_words);
  grid.sync();
#define GSYNC() xcd_barrier(xb)
#endif
  const int G = gridDim.x, bid = blockIdx.x;
  unsigned char* ws = p.ws;
  if (PHM & 1) phase0(p, smem);
  GSYNC();
  for (int l = 0; l < 2; ++l) {
    if (PHM & 2) cache_to_kv(p, l);
    for (int rep = 0; rep < ((DBL & 1) ? 2 : 1); ++rep)
    if (PHM & 2) for (int it = bid; it < 132 * 34; it += G) p1_tile(p, l, it % 132, it / 132, smem);
    { float* rq2 = (float*)(ws + OFF_ROWSQ2); for (int i = bid * NT + threadIdx.x; i < T; i += G * NT) rq2[i] = 0.f; }
    GSYNC();
    for (int it = bid; it < 264 * 8 + 512 + 264 * 2; it += G) {
      if (it < 2112) { if (PHM & 4) attn_item<true>(p, l, it >> 3, it & 7, smem); }
      else if (it < 2624) { const int j = it - 2112; if (PHM & 8) hgrn_item<false>(p, l, j >> 2, j & 3, smem); }
      else { const int j = it - 2624; if (PHM & 16) attn_item<false>(p, l, j >> 1, j & 1, smem); }
    }
    GSYNC();
    if (PHM & 32) hgrn_scan(p, l);
    GSYNC();
    if (PHM & 64) for (int it = bid; it < 136 * 4; it += G) hgrn_item<true>(p, l, it >> 2, it & 3, smem);
    GSYNC();
    if (PHM & 128) for (int it = bid; it < NCONV_FFN; it += G) conv_wffn_item(p, l, it, smem);
    for (int rep = 0; rep < ((DBL & 2) ? 2 : 1); ++rep)
    if (PHM & 256) for (int it = bid; it < 132 * 16; it += G) p5_tile(p, l, it % 132, it / 132, smem);
    GSYNC();
    { float* rq1 = (float*)(ws + OFF_ROWSQ1); for (int i = bid * NT + threadIdx.x; i < T; i += G * NT) rq1[i] = 0.f; }
    if (PHM & 512) for (int it = bid; it < 132 * 8; it += G)
      resid_tile(p, (const u16*)(ws + OFF_MIX), 1024, (const u16*)(ws + OFF_WOUT), 1024, (float*)(ws + OFF_ROWSQ2), it % 132, it / 132, smem);
    GSYNC();
    for (int rep = 0; rep < ((DBL & 4) ? 2 : 1); ++rep)
    if (PHM & 1024) for (int it = bid; it < 135 * 44; it += G) p7_tile(p, l, it % 135, it / 135, smem);
    GSYNC();
    if (l == 0) for (int it = bid; it < NCONV_MIX; it += G) conv_wmix_item(p, 1, it, smem);
    if (PHM & 2048) for (int it = bid; it < 132 * 8; it += G)
      resid_tile(p, (const u16*)(ws + OFF_ACT), DFF, (const u16*)(ws + OFF_WDOWN), DFF, (float*)(ws + OFF_ROWSQ1), it % 132, it / 132, smem);
    GSYNC();
  }
  final_norm(p);
}

extern "C" void kernel_launch(void* const* d_in, const int* in_sizes, int n_in, void* d_out, int out_size,
                              void* d_ws, size_t ws_size, hipStream_t stream) {
  static int grid_blocks = 0;
  if (!grid_blocks) {
    int dev = 0, cus = 0, per_cu = 0;
    hipGetDevice(&dev);
    hipDeviceGetAttribute(&cus, hipDeviceAttributeMultiprocessorCount, dev);
    hipFuncSetAttribute((const void*)fwd_megakernel, hipFuncAttributeMaxDynamicSharedMemorySize, LDS_BYTES);
    hipOccupancyMaxActiveBlocksPerMultiprocessor(&per_cu, (const void*)fwd_megakernel, NT, LDS_BYTES);
    if (per_cu < 1) per_cu = 1;
    if (per_cu > 2) per_cu = 2;
    grid_blocks = cus * per_cu;
    if (ws_size < WS_END || (size_t)out_size < O_END || n_in < 24)
      fprintf(stderr, "kernel_launch: unexpected sizes ws=%zu need=%zu out=%d need=%zu n_in=%d\n", ws_size, (size_t)WS_END, out_size, (size_t)O_END, n_in);
  }
  Params p{};
  for (int i = 0; i < 24; ++i) p.in[i] = (const float*)d_in[i];
  p.out = (float*)d_out; p.ws = (unsigned char*)d_ws;
  hipMemsetAsync((char*)d_ws + OFF_BAR, 0, 16384, stream);
  void* args[] = {&p};
  hipError_t e = hipLaunchCooperativeKernel((const void*)fwd_megakernel, dim3(grid_blocks), dim3(NT), args, LDS_BYTES, stream);
  if (e != hipSuccess) fprintf(stderr, "cooperative launch failed: %s (grid %d)\n", hipGetErrorString(e), grid_blocks);
}
```

```cpp
#include <hip/hip_runtime.h>
#include <hip/hip_cooperative_groups.h>
#include <cstdio>
namespace cg = cooperative_groups;

typedef unsigned short u16;
using bf16x8 = __attribute__((ext_vector_type(8))) short;
using f32x4 = __attribute__((ext_vector_type(4))) float;
#define DI __device__ __forceinline__
#define MFMA16(a, b, c) __builtin_amdgcn_mfma_f32_16x16x32_bf16((a), (b), (c), 0, 0, 0)

#ifndef PHM
#define PHM 0xFFFF
#endif
#ifndef DBL
#define DBL 0
#endif
#ifndef TPROBE
#define TPROBE 0
#endif
#ifndef TILE_GR
#define TILE_GR 8
#endif
#ifndef USE_CG_SYNC
#define USE_CG_SYNC 0
#endif

constexpr int DM = 1024, TP = 16384, TS = 512, T = TP + TS, NBATCH = 8;
constexpr int INW = 7424, NIN1 = 4352;
constexpr int DFF = 2816, DFF2 = 5632;
constexpr int KA_ROWS = TP + NBATCH * 192, KB_ROWS = TP + NBATCH * 576;
constexpr int NT = 256;
constexpr float EPS = 1e-6f;
constexpr int LDX = 1088, LDW1 = 1088, LDW5 = 576, LDACT = 2880;
constexpr int LDS_BYTES = 73728 + 1024;

constexpr size_t OFF_BAR   = 0;
constexpr size_t OFF_ROWSQ1 = 16384;
constexpr size_t OFF_ROWSQ2 = OFF_ROWSQ1 + 67584;
constexpr size_t OFF_DECAY = OFF_ROWSQ2 + 67584;
constexpr size_t OFF_WMIX  = OFF_DECAY + 262144;
constexpr size_t W_IN_B = (size_t)INW * LDW1 * 2, W_BR_B = (size_t)1024 * LDW5 * 2, W_OUT_B = (size_t)1024 * LDW1 * 2;
constexpr size_t OFF_WIN = OFF_WMIX, OFF_WA = OFF_WIN + W_IN_B, OFF_WB = OFF_WA + W_BR_B, OFF_WC = OFF_WB + W_BR_B, OFF_WOUT = OFF_WC + W_BR_B;
constexpr size_t OFF_XB    = OFF_WOUT + W_OUT_B;
constexpr size_t OFF_ST    = OFF_XB + (size_t)T * LDX * 2;
constexpr size_t OFF_WUP = OFF_ST, OFF_WDOWN = OFF_ST + (size_t)DFF2 * LDW1 * 2;
static_assert(OFF_WDOWN + (size_t)1024 * LDACT * 2 <= OFF_ST + (size_t)128 * 4 * 16384 * 4, "ffn weights fit the state region");
constexpr size_t OFF_QA    = OFF_ST + (size_t)128 * 4 * 16384 * 4;
constexpr size_t PLANE = (size_t)T * 512 * 2;
constexpr size_t OFF_QB    = OFF_QA + PLANE;
constexpr size_t OFF_KA    = OFF_QB + PLANE;
constexpr size_t OFF_VTA   = OFF_KA + (size_t)KA_ROWS * 128 * 2;
constexpr size_t OFF_KB    = OFF_VTA + (size_t)KA_ROWS * 128 * 2;
constexpr size_t OFF_VTB   = OFF_KB + (size_t)KB_ROWS * 512 * 2;
constexpr size_t OFF_HF    = OFF_VTB + (size_t)KB_ROWS * 512 * 2;
constexpr size_t OFF_HI = OFF_HF + PLANE, OFF_HQ = OFF_HI + PLANE, OFF_HOG = OFF_HQ + PLANE;
constexpr size_t WS_END = OFF_HOG + PLANE;
constexpr size_t OFF_P5S = WS_END;
constexpr size_t WS_END2 = OFF_P5S + (size_t)512 * 32768;
static_assert(WS_END2 <= (size_t)256 * 1024 * 1024, "workspace budget");
constexpr size_t OFF_MIX = OFF_KB;
static_assert((size_t)T * LDX * 2 <= 2 * (size_t)KB_ROWS * 512 * 2, "mix fits");
constexpr size_t OFF_ACT = OFF_QA;
static_assert(OFF_ACT + (size_t)T * LDACT * 2 <= OFF_HQ, "act fits");

constexpr size_t O_X = 0;
constexpr size_t O_AKP = (size_t)T * 1024;
constexpr size_t O_AVP = O_AKP + 32768;
constexpr size_t O_BKP = O_AVP + 32768;
constexpr size_t O_BVP = O_BKP + 524288;
constexpr size_t O_CP  = O_BVP + 524288;
constexpr size_t O_CVP = O_CP + 131072;
constexpr size_t O_AKS = O_CVP + 22528;
constexpr size_t O_AVS = O_AKS + 262144;
constexpr size_t O_BKS = O_AVS + 262144;
constexpr size_t O_BVS = O_BKS + 4194304;
constexpr size_t O_CS  = O_BVS + 4194304;
constexpr size_t O_CVS = O_CS + 1048576;
constexpr size_t O_END = O_CVS + 180224;

struct Params { const float* in[24]; float* out; unsigned char* ws; };

DI u16 f2bf(float x) { unsigned u = __float_as_uint(x); u += 0x7fffu + ((u >> 16) & 1u); return (u16)(u >> 16); }
DI float bf2f(u16 v) { return __uint_as_float(((unsigned)v) << 16); }
typedef __bf16 bf16x2_t __attribute__((ext_vector_type(2)));
DI unsigned pack2(float a, float b) { bf16x2_t v = {(__bf16)a, (__bf16)b}; return __builtin_bit_cast(unsigned, v); }
DI float lo_f(unsigned u) { return __uint_as_float(u << 16); }
DI float hi_f(unsigned u) { return __uint_as_float(u & 0xffff0000u); }
DI float wave_sum(float v) {
#pragma unroll
  for (int o = 32; o >= 1; o >>= 1) v += __shfl_xor(v, o, 64);
  return v;
}
DI int tidx() { int t = threadIdx.x; asm volatile("" : "+v"(t)); return t; }
DI float rcpf_(float x) { return __builtin_amdgcn_rcpf(x); }
DI float sigmoidf_(float x) { return rcpf_(1.f + __expf(-x)); }
DI int krowA(int tok) { if (tok < TP) return tok; int s = tok - TP; return TP + (s >> 6) * 192 + 128 + (s & 63); }
DI int krowB(int tok) { if (tok < TP) return tok; int s = tok - TP; return TP + (s >> 6) * 576 + 512 + (s & 63); }

#define XB_TMO      128
#define XB_XCNT(j)  (256  + 64 * (j))
#define XB_XSUB(j)  (1280 + 64 * (j))
#define XB_XGEN(j)  (2304 + 64 * (j))
#define XB_TOP      3328
#define XB_TOPGEN   3392
#define XCD_BAR_WORDS 3456
#define XB_SPIN_CAP (1u << 24)
#define LAS __attribute__((address_space(3)))
DI unsigned xb_ld(unsigned* p) { return __hip_atomic_load(p, __ATOMIC_RELAXED, __HIP_MEMORY_SCOPE_AGENT); }
DI unsigned xb_add(unsigned* p, unsigned v) { return __hip_atomic_fetch_add(p, v, __ATOMIC_RELAXED, __HIP_MEMORY_SCOPE_AGENT); }
DI unsigned xb_xcc_id() { return (unsigned)__builtin_amdgcn_s_getreg((3 << 11) | 20) & 0xFu; }
#define XB_SPIN(cond, bar) do { unsigned _sp = 0; while (cond) { __builtin_amdgcn_s_sleep(1); \
    if ((++_sp & 255u) == 0u) { if (xb_ld(&(bar)[XB_TMO])) break; if (_sp > XB_SPIN_CAP) { atomicAdd(&(bar)[XB_TMO], 1u); break; } } } } while (0)
struct XcdBarrier { unsigned* bar; unsigned x; volatile LAS unsigned* st; };
DI XcdBarrier xcd_barrier_post(unsigned* bar, volatile LAS unsigned* st) {
  XcdBarrier b; b.bar = bar; b.x = xb_xcc_id(); b.st = st;
  if (threadIdx.x == 0) st[2] = xb_add(&bar[XB_XCNT(b.x)], 1u);
  return b;
}
DI void xcd_barrier_complete(unsigned* bar, unsigned x, unsigned& nloc, unsigned& nx) {
  const unsigned G = gridDim.x;
  unsigned sum, cnt, mine, sp = 0u;
  for (;;) {
    sum = 0u; cnt = 0u; mine = 0u;
#pragma unroll
    for (unsigned j = 0; j < 16; ++j) { const unsigned c = xb_ld(&bar[XB_XCNT(j)]); sum += c; cnt += (c > 0u) ? 1u : 0u; mine = (j == x) ? c : mine; }
    if (sum == G) break;
    __builtin_amdgcn_s_sleep(1);
    if ((++sp & 255u) == 0u) { if (xb_ld(&bar[XB_TMO])) break; if (sp > XB_SPIN_CAP) { atomicAdd(&bar[XB_TMO], 1u); break; } }
  }
  nloc = mine > 0u ? mine : 1u; nx = cnt > 0u ? cnt : 1u;
}
DI void xcd_barrier(const XcdBarrier& b) {
  asm volatile("s_waitcnt vmcnt(0)" ::: "memory");
  __syncthreads();
  if (threadIdx.x == 0) {
    unsigned* bar = b.bar;
    __builtin_amdgcn_s_waitcnt(0);
    unsigned nloc = b.st[0], nx = b.st[1];
    if (nloc == 0u) { xcd_barrier_complete(bar, b.x, nloc, nx); b.st[0] = nloc; b.st[1] = nx; }
    const unsigned old = xb_add(&bar[XB_XSUB(b.x)], 1u);
    const unsigned gen = old / nloc;
    if (old + 1u == (gen + 1u) * nloc) {
      __builtin_amdgcn_fence(__ATOMIC_RELEASE, "agent");
      asm volatile("s_waitcnt vmcnt(0)" ::: "memory");
      const unsigned og = xb_add(&bar[XB_TOP], 1u);
      const unsigned tg = og / nx;
      if (og + 1u == (tg + 1u) * nx) xb_add(&bar[XB_TOPGEN], 1u);
      else XB_SPIN(xb_ld(&bar[XB_TOPGEN]) == tg, bar);
      __builtin_amdgcn_fence(__ATOMIC_ACQUIRE, "agent");
      xb_add(&bar[XB_XGEN(b.x)], 1u);
      asm volatile("s_waitcnt vmcnt(0)" ::: "memory");
    } else {
      XB_SPIN(xb_ld(&bar[XB_XGEN(b.x)]) == gen, bar);
      __builtin_amdgcn_fence(__ATOMIC_ACQUIRE, "agent");
      asm volatile("s_waitcnt vmcnt(0)" ::: "memory");
    }
  }
  __syncthreads();
}

template <int NB>
DI void gemm_tile(f32x4 (&acc)[4][NB], const u16* __restrict__ A, int lda, int row0, int lo, int hi,
                  const u16* __restrict__ W, int ldw, int K, char* smem) {
  const int tid = tidx(), lane = tid & 63, wid = tid >> 6, wr = wid >> 1, wc = wid & 1, fr = lane & 15, fq = lane >> 4;
  const int sr = tid >> 3, sc = tid & 7;
#pragma unroll
  for (int m = 0; m < 4; ++m)
#pragma unroll
    for (int n = 0; n < NB; ++n) acc[m][n] = f32x4{0.f, 0.f, 0.f, 0.f};
  const int g0 = row0 + sr;
  const int c0r = min(max(g0, lo), hi - 1), c1r = min(max(g0 + 32, lo), hi - 1), c2r = min(max(g0 + 64, lo), hi - 1), c3r = min(max(g0 + 96, lo), hi - 1);
  const int csw = (sc ^ ((sr >> 1) & 7)) * 8;
  const u16* ap0 = A + (size_t)c0r * lda + csw;
  const u16* ap1 = A + (size_t)c1r * lda + csw;
  const u16* ap2 = A + (size_t)c2r * lda + csw;
  const u16* ap3 = A + (size_t)c3r * lda + csw;
  const u16* wp = W + (size_t)sr * ldw + csw;
  const size_t ws32 = (size_t)32 * ldw;
  int koff = 0;
  char* sdst = smem + tid * 16;
#define GLDS(g, l) __builtin_amdgcn_global_load_lds((const __attribute__((address_space(1))) unsigned*)(g), (__attribute__((address_space(3))) unsigned*)(l), 16, 0, 0)
#define STAGE(buf) do { char* d_ = sdst + (buf) * 32768; \
    GLDS(ap0 + koff, d_); GLDS(ap1 + koff, d_ + 4096); GLDS(ap2 + koff, d_ + 8192); GLDS(ap3 + koff, d_ + 12288); \
    GLDS(wp + koff, d_ + 16384); if (NB > 1) GLDS(wp + ws32 + koff, d_ + 16384 + 4096); \
    if (NB > 2) { GLDS(wp + 2 * ws32 + koff, d_ + 16384 + 8192); GLDS(wp + 3 * ws32 + koff, d_ + 16384 + 12288); } \
    koff += 64; } while (0)
  const int fsw = (fr >> 1) & 7;
  const int fa = (wr * 64 + fr) * 128, fb = 16384 + (wc * (NB * 16) + fr) * 128;
#define COMPUTE(buf) do { const char* b = smem + (buf) * 32768; \
    _Pragma("unroll") for (int kk = 0; kk < 2; ++kk) { \
      bf16x8 af[4], bfr[NB]; \
      const int co = ((kk * 4 + fq) ^ fsw) * 16; \
      _Pragma("unroll") for (int m = 0; m < 4; ++m) af[m] = *(const bf16x8*)(b + fa + m * 2048 + co); \
      _Pragma("unroll") for (int n = 0; n < NB; ++n) bfr[n] = *(const bf16x8*)(b + fb + n * 2048 + co); \
      __builtin_amdgcn_s_setprio(1); \
      _Pragma("unroll") for (int m = 0; m < 4; ++m) \
        _Pragma("unroll") for (int n = 0; n < NB; ++n) acc[m][n] = MFMA16(af[m], bfr[n], acc[m][n]); \
      __builtin_amdgcn_s_setprio(0); \
    } } while (0)
  const int nk = K >> 6;
  STAGE(0);
  asm volatile("s_waitcnt vmcnt(0)" ::: "memory");
  __syncthreads();
#pragma unroll 4
  for (int kt = 0; kt < nk; ++kt) {
    if (kt + 1 < nk) STAGE((kt + 1) & 1);
    COMPUTE(kt & 1);
    asm volatile("s_waitcnt vmcnt(0)" ::: "memory");
    __syncthreads();
  }
#undef GLDS
#undef STAGE
#undef COMPUTE
}

constexpr int CTS = 132;
template <int NB>
DI void acc_to_lds(const f32x4 (&acc)[4][NB], float* Ct, const float* rs) {
  const int tid = tidx(), lane = tid & 63, wid = tid >> 6, wr = wid >> 1, wc = wid & 1, fr = lane & 15, fq = lane >> 4;
#pragma unroll
  for (int m = 0; m < 4; ++m)
#pragma unroll
    for (int j = 0; j < 4; ++j) {
      const int r = wr * 64 + m * 16 + fq * 4 + j;
      const float s = rs ? rs[r] : 1.f;
#pragma unroll
      for (int n = 0; n < NB; ++n) Ct[r * CTS + wc * (NB * 16) + n * 16 + fr] = acc[m][n][j] * s;
    }
  __syncthreads();
}

DI void conv_wtile(const float* __restrict__ src, int K, int N, u16* __restrict__ dst, int ldk, const float* __restrict__ gain, int permute, int tile, float* tl) {
  const int tid = tidx();
  const int nnt = N >> 6; const int kt = tile / nnt, nt = tile - kt * nnt; const int k0 = kt * 64, n0 = nt * 64;
  {
    const int n = tid & 63, kq = tid >> 6;
    float v16[16];
#pragma unroll
    for (int i = 0; i < 16; ++i) v16[i] = src[(size_t)(k0 + i * 4 + kq) * N + n0 + n];
#pragma unroll
    for (int i = 0; i < 16; ++i) { const int k = i * 4 + kq; float v = v16[i]; if (gain) v *= gain[k0 + k]; tl[k * 65 + n] = v; }
  }
  __syncthreads();
#pragma unroll
  for (int j = 0; j < 2; ++j) {
    const int n = (tid >> 3) + 32 * j, ks = tid & 7;
    float v[8];
#pragma unroll
    for (int q = 0; q < 8; ++q) v[q] = tl[(ks * 8 + q) * 65 + n];
    int nn = n0 + n;
    if (permute) nn = (nn < DFF) ? ((nn >> 6) * 128 + (nn & 63)) : ((((nn - DFF) >> 6) * 128) + 64 + ((nn - DFF) & 63));
    uint4 pk = make_uint4(pack2(v[0], v[1]), pack2(v[2], v[3]), pack2(v[4], v[5]), pack2(v[6], v[7]));
    *(uint4*)(dst + (size_t)nn * ldk + k0 + ks * 8) = pk;
  }
  __syncthreads();
}
constexpr int NCONV_MIX = 1856 + 3 * 128 + 256;
constexpr int NCONV_FFN = 1408 + 704;
DI void conv_wmix_item(const Params& p, int l, int it, char* smem) {
  float* tl = (float*)smem; unsigned char* ws = p.ws;
  if (it < 1856) conv_wtile(p.in[9] + (size_t)l * 1024 * INW, 1024, INW, (u16*)(ws + OFF_WIN), LDW1, p.in[8] + l * 1024, 0, it, tl);
  else if (it < 1856 + 384) { const int b = (it - 1856) >> 7, t = (it - 1856) & 127;
    conv_wtile(p.in[14 + b] + (size_t)l * 512 * 1024, 512, 1024, (u16*)(ws + OFF_WA + b * W_BR_B), LDW5, nullptr, 0, t, tl); }
  else conv_wtile(p.in[17] + (size_t)l * 1024 * 1024, 1024, 1024, (u16*)(ws + OFF_WOUT), LDW1, nullptr, 0, it - 2240, tl);
}
DI void conv_wffn_item(const Params& p, int l, int it, char* smem) {
  float* tl = (float*)smem; unsigned char* ws = p.ws;
  if (it < 1408) conv_wtile(p.in[19] + (size_t)l * 1024 * DFF2, 1024, DFF2, (u16*)(ws + OFF_WUP), LDW1, p.in[18] + l * 1024, 1, it, tl);
  else conv_wtile(p.in[22] + (size_t)l * DFF * 1024, DFF, 1024, (u16*)(ws + OFF_WDOWN), LDACT, nullptr, 0, it - 1408, tl);
}

DI void phase0(const Params& p, char* smem) {
  const int tid = tidx(), lane = tid & 63, wid = tid >> 6;
  float* x = p.out; u16* xb = (u16*)(p.ws + OFF_XB);
  float* rowsq1 = (float*)(p.ws + OFF_ROWSQ1); float* rowsq2 = (float*)(p.ws + OFF_ROWSQ2);
  for (int it = blockIdx.x; it < T / 4; it += gridDim.x) {
    const int row = it * 4 + wid;
    const float* src = row < TP ? p.in[0] + (size_t)row * 1024 : p.in[1] + (size_t)(row - TP) * 1024;
    float ss = 0.f;
#pragma unroll
    for (int i = 0; i < 4; ++i) {
      const int c = (i * 64 + lane) * 4;
      const float4 v = *(const float4*)(src + c);
      *(float4*)(x + (size_t)row * 1024 + c) = v;
      ss += v.x * v.x + v.y * v.y + v.z * v.z + v.w * v.w;
      *(uint2*)(xb + (size_t)row * LDX + c) = make_uint2(pack2(v.x, v.y), pack2(v.z, v.w));
    }
    ss = wave_sum(ss);
    if (lane == 0) { rowsq1[row] = ss; rowsq2[row] = 0.f; }
  }
  for (int it = blockIdx.x; it < NCONV_MIX; it += gridDim.x) conv_wmix_item(p, 0, it, smem);
  const size_t gsz = (size_t)gridDim.x * NT, g0 = (size_t)blockIdx.x * NT + tid;
  for (size_t e = g0; e < (size_t)2 * 8 * 64 * 128; e += gsz) {
    const size_t lb = e / (64 * 128), r = e % (64 * 128);
    p.out[O_AKS + lb * 128 * 128 + r] = p.in[2][lb * 128 * 128 + 64 * 128 + r];
    p.out[O_AVS + lb * 128 * 128 + r] = p.in[3][lb * 128 * 128 + 64 * 128 + r];
  }
  for (size_t e = g0; e < (size_t)2 * 8 * 448 * 512 / 4; e += gsz) {
    const size_t e4 = e * 4; const size_t lb = e4 / (448 * 512), r = e4 % (448 * 512);
    *(float4*)(p.out + O_BKS + lb * 512 * 512 + r) = *(const float4*)(p.in[4] + lb * 512 * 512 + 64 * 512 + r);
    *(float4*)(p.out + O_BVS + lb * 512 * 512 + r) = *(const float4*)(p.in[5] + lb * 512 * 512 + 64 * 512 + r);
  }
}

DI void cache_to_kv(const Params& p, int l) {
  const int tid = tidx();
  const size_t gsz = (size_t)gridDim.x * NT, g0 = (size_t)blockIdx.x * NT + tid;
  u16* Ka = (u16*)(p.ws + OFF_KA); u16* Vta = (u16*)(p.ws + OFF_VTA); u16* Kb = (u16*)(p.ws + OFF_KB); u16* Vtb = (u16*)(p.ws + OFF_VTB);
  for (size_t e = g0; e < (size_t)8 * 128 * 128 / 8; e += gsz) {
    const size_t e8 = e * 8; const int b = (int)(e8 / (128 * 128)); const int j = (int)((e8 / 128) % 128), c = (int)(e8 % 128);
    const float* s = p.in[2] + ((size_t)(l * 8 + b) * 128 + j) * 128 + c;
    const float4 v0 = *(const float4*)s, v1 = *(const float4*)(s + 4);
    *(uint4*)(Ka + (size_t)(TP + b * 192 + j) * 128 + c) = make_uint4(pack2(v0.x, v0.y), pack2(v0.z, v0.w), pack2(v1.x, v1.y), pack2(v1.z, v1.w));
  }
  for (size_t e = g0; e < (size_t)8 * 512 * 512 / 8; e += gsz) {
    const size_t e8 = e * 8; const int b = (int)(e8 / (512 * 512)); const int j = (int)((e8 / 512) % 512), c = (int)(e8 % 512);
    const float* s = p.in[4] + ((size_t)(l * 8 + b) * 512 + j) * 512 + c;
    const float4 v0 = *(const float4*)s, v1 = *(const float4*)(s + 4);
    *(uint4*)(Kb + (size_t)(TP + b * 576 + j) * 512 + c) = make_uint4(pack2(v0.x, v0.y), pack2(v0.z, v0.w), pack2(v1.x, v1.y), pack2(v1.z, v1.w));
  }
  for (size_t e = g0; e < (size_t)8 * 16 * 128; e += gsz) {
    const int c = (int)(e % 128), j8 = (int)((e / 128) % 16), b = (int)(e / (128 * 16));
    const float* s = p.in[3] + ((size_t)(l * 8 + b) * 128 + j8 * 8) * 128 + c;
    float v[8];
#pragma unroll
    for (int q = 0; q < 8; ++q) v[q] = s[(size_t)q * 128];
    *(uint4*)(Vta + (size_t)c * KA_ROWS + TP + b * 192 + j8 * 8) = make_uint4(pack2(v[0], v[1]), pack2(v[2], v[3]), pack2(v[4], v[5]), pack2(v[6], v[7]));
  }
  for (size_t e = g0; e < (size_t)8 * 64 * 512; e += gsz) {
    const int c = (int)(e % 512), j8 = (int)((e / 512) % 64), b = (int)(e / (512 * 64));
    const float* s = p.in[5] + ((size_t)(l * 8 + b) * 512 + j8 * 8) * 512 + c;
    float v[8];
#pragma unroll
    for (int q = 0; q < 8; ++q) v[q] = s[(size_t)q * 512];
    *(uint4*)(Vtb + (size_t)c * KB_ROWS + TP + b * 576 + j8 * 8) = make_uint4(pack2(v[0], v[1]), pack2(v[2], v[3]), pack2(v[4], v[5]), pack2(v[6], v[7]));
  }
}

DI void p1_tile(const Params& p, int l, int rt, int ct, char* smem) {
  const int tid = tidx();
  unsigned char* ws = p.ws;
  float* Ct = (float*)smem; float* rs = (float*)(smem + 73728);
  const float* rowsq1 = (const float*)(ws + OFF_ROWSQ1);
  const int row0 = rt * 128;
  if (tid < 128) rs[tid] = rsqrtf(rowsq1[row0 + tid] * (1.f / 1024.f) + EPS);
  f32x4 acc[4][4];
  gemm_tile<4>(acc, (const u16*)(ws + OFF_XB), LDX, row0, 0, T, (const u16*)(ws + OFF_WIN) + (size_t)ct * 128 * LDW1, LDW1, 1024, smem);
  acc_to_lds<4>(acc, Ct, rs);
  int kind, cb;
  u16* dst; int dstw;
  bool isB = false; int hplane = 0;
  if (ct < 4)       { kind = 0; cb = ct * 128;        dst = (u16*)(ws + OFF_QA); dstw = 512; }
  else if (ct == 4) { kind = 1; cb = 0;               dst = (u16*)(ws + OFF_KA); dstw = 128; }
  else if (ct == 5) { kind = 2; cb = 0;               dst = (u16*)(ws + OFF_VTA); dstw = 128; }
  else if (ct < 10) { kind = 3; cb = (ct - 6) * 128;  dst = (u16*)(ws + OFF_QB); dstw = 512; isB = true; }
  else if (ct < 14) { kind = 4; cb = (ct - 10) * 128; dst = (u16*)(ws + OFF_KB); dstw = 512; isB = true; }
  else if (ct < 18) { kind = 2; cb = (ct - 14) * 128; dst = (u16*)(ws + OFF_VTB); dstw = 512; isB = true; }
  else { kind = 3; hplane = (ct - 18) >> 2; cb = ((ct - 18) & 3) * 128; dst = (u16*)(ws + OFF_HF + (size_t)hplane * PLANE); dstw = 512; }
  const bool rope = (kind == 0 || kind == 1);
  const bool iskv = (kind == 1 || kind == 2 || kind == 4);
  const int R = isB ? 512 : 128;
  float* cache_p = nullptr; float* cache_s = nullptr;
  if (iskv) {
    const bool isv = (kind == 2);
    cache_p = p.out + (isB ? (isv ? O_BVP : O_BKP) : (isv ? O_AVP : O_AKP)) + (size_t)l * R * dstw;
    cache_s = p.out + (isB ? (isv ? O_BVS : O_BKS) : (isv ? O_AVS : O_AKS)) + (size_t)l * 8 * R * dstw;
  }
#pragma unroll 1
  for (int i = 0; i < 4; ++i) {
    const int item = tid + NT * i; const int r = item >> 3, g = item & 7;
    const int tok = row0 + r;
    float v[16];
#pragma unroll
    for (int q = 0; q < 4; ++q) { const float4 t4 = *(const float4*)(Ct + r * CTS + g * 16 + q * 4); v[q * 4] = t4.x; v[q * 4 + 1] = t4.y; v[q * 4 + 2] = t4.z; v[q * 4 + 3] = t4.w; }
    if (rope && (g & 3) == 0) {
      const float pos = (float)(tok < TP ? tok : 1024 + ((tok - TP) & 63));
#pragma unroll
      for (int d = 0; d < 8; ++d) {
        const float invf = exp2f(-(float)d * (18.931568569324174f / 8.f));
        float sn, cs; sincosf(pos * invf, &sn, &cs);
        const float x1 = v[d], x2 = v[d + 8];
        v[d] = x1 * cs - x2 * sn; v[d + 8] = x2 * cs + x1 * sn;
      }
    }
    const int col = cb + g * 16;
    if (kind != 2) {
      size_t drow;
      if (kind == 1) drow = (size_t)krowA(tok); else if (kind == 4) drow = (size_t)krowB(tok); else drow = (size_t)tok;
      u16* d = dst + drow * dstw + col;
      *(uint4*)d = make_uint4(pack2(v[0], v[1]), pack2(v[2], v[3]), pack2(v[4], v[5]), pack2(v[6], v[7]));
      *(uint4*)(d + 8) = make_uint4(pack2(v[8], v[9]), pack2(v[10], v[11]), pack2(v[12], v[13]), pack2(v[14], v[15]));
    }
    if (iskv) {
      float* cd = nullptr;
      if (tok < TP) { if (tok >= TP - R) cd = cache_p + (size_t)(tok - (TP - R)) * dstw + col; }
      else { const int s = tok - TP; cd = cache_s + ((size_t)(s >> 6) * R + (R - 64) + (s & 63)) * dstw + col; }
      if (cd) {
#pragma unroll
        for (int q = 0; q < 4; ++q) *(float4*)(cd + q * 4) = make_float4(v[q * 4], v[q * 4 + 1], v[q * 4 + 2], v[q * 4 + 3]);
      }
    }
  }
  if (kind == 2) {
    const int ROWS = isB ? KB_ROWS : KA_ROWS;
#pragma unroll 1
    for (int i = 0; i < 8; ++i) {
      const int item = tid + NT * i; const int g8 = item & 15, c = item >> 4;
      float v[8];
#pragma unroll
      for (int q = 0; q < 8; ++q) v[q] = Ct[(g8 * 8 + q) * CTS + c];
      const int tok = row0 + g8 * 8;
      const int kr = isB ? krowB(tok) : krowA(tok);
      *(uint4*)(dst + (size_t)(cb + c) * ROWS + kr) = make_uint4(pack2(v[0], v[1]), pack2(v[2], v[3]), pack2(v[4], v[5]), pack2(v[6], v[7]));
    }
  }
  __syncthreads();
}

constexpr int AT_KS = 2048;
template <bool ISB>
DI void attn_item(const Params& p, int l, int sc, int hh, char* smem) {
  constexpr int GB = ISB ? 6 : 12;
  constexpr int NG = ISB ? 6 : 1, NQH = ISB ? 1 : 4;
  constexpr int NCH = GB / 2;
  constexpr int VROW = (GB * 16 + 8) * 2;
  constexpr int AT_VS = AT_KS + GB * 16 * 144;
  const int tid = tidx(), lane = tid & 63, wid = tid >> 6, fr = lane & 15, fq = lane >> 4;
  constexpr int KW = ISB ? 512 : 128;
  constexpr int KROWS = ISB ? KB_ROWS : KA_ROWS;
  constexpr int R = ISB ? 512 : 128;
  u16* Q = (u16*)(p.ws + (ISB ? OFF_QB : OFF_QA));
  const u16* Kp = (const u16*)(p.ws + (ISB ? OFF_KB : OFF_KA));
  const u16* Vt = (const u16*)(p.ws + (ISB ? OFF_VTB : OFF_VTA));
  int tokq0, kband0, firstblk;
  if (sc < 256) { tokq0 = sc * 64; kband0 = sc * 64 - R; firstblk = kband0 < 0 ? ((-kband0) >> 4) : 0; }
  else { const int b = sc - 256; tokq0 = TP + b * 64; kband0 = TP + b * (R + 64); firstblk = 0; }
  const int hk = hh;
  const int qrow = tokq0 + wid * 16 + fr;
  const float* table = (const float*)smem;
  float tconst = 0.f;
  __syncthreads();
  if (ISB) {
    const float* gt = p.in[11] + (size_t)(l * 8 + hh) * 257;
    float* tw = (float*)smem;
    tw[tid] = gt[tid]; if (tid < 64) tw[256 + tid] = gt[256];
  }
  const int qi = wid * 16 + fr;
  const float* eb = table + (65 + qi - fq * 4);
  float m_run = -1e30f, l_run = 0.f;
  f32x4 o[4];
#pragma unroll
  for (int d = 0; d < 4; ++d) o[d] = f32x4{0.f, 0.f, 0.f, 0.f};
  bf16x8 qf[2];
  if (NQH == 1) {
#pragma unroll
    for (int kk = 0; kk < 2; ++kk) qf[kk] = *(const bf16x8*)(Q + (size_t)qrow * 512 + hh * 64 + kk * 32 + fq * 8);
  }
  uint4 kreg[NCH], vreg[NCH];
#define AT_LOAD(g_) do { const int fbl = max(firstblk - (g_) * GB, 0); const int kbl = kband0 + (g_) * (GB * 16); \
    _Pragma("unroll") for (int i = 0; i < NCH; ++i) { const int c = tid + NT * i; \
      { const int row = c >> 3, ch = c & 7; kreg[i] = make_uint4(0u, 0u, 0u, 0u); \
        if (row >= fbl * 16) kreg[i] = *(const uint4*)(Kp + (size_t)(kbl + row) * KW + hk * 64 + ch * 8); } \
      { const int row = c / (GB * 2), ch = c - row * (GB * 2); vreg[i] = make_uint4(0u, 0u, 0u, 0u); \
        if (ch * 8 >= fbl * 16) vreg[i] = *(const uint4*)(Vt + (size_t)(hk * 64 + row) * KROWS + kbl + ch * 8); } } } while (0)
#define AT_STORE() do { _Pragma("unroll") for (int i = 0; i < NCH; ++i) { const int c = tid + NT * i; \
      { const int row = c >> 3, ch = c & 7; *(uint4*)(smem + AT_KS + row * 144 + ch * 16) = kreg[i]; } \
      { const int row = c / (GB * 2), ch = c - row * (GB * 2); *(uint4*)(smem + AT_VS + row * VROW + ch * 16) = vreg[i]; } } } while (0)
  const int g0 = firstblk / GB;
  AT_LOAD(g0);
  AT_STORE();
  __syncthreads();
  if (ISB) tconst = table[256];
#pragma unroll 1
  for (int g = g0; g < NG; ++g) {
    const int fb = max(firstblk - g * GB, 0);
    if (g + 1 < NG) AT_LOAD(g + 1);
    __builtin_amdgcn_sched_barrier(0);
#pragma unroll 1
    for (int qh = 0; qh < NQH; ++qh) {
      const int h = ISB ? hh : hh * 4 + qh;
      if (NQH > 1) {
#pragma unroll
        for (int kk = 0; kk < 2; ++kk) qf[kk] = *(const bf16x8*)(Q + (size_t)qrow * 512 + h * 64 + kk * 32 + fq * 8);
        m_run = p.in[10][l * 8 + h]; l_run = 1.f;
#pragma unroll
        for (int d = 0; d < 4; ++d) o[d] = f32x4{0.f, 0.f, 0.f, 0.f};
      }
      f32x4 s[GB];
#pragma unroll
      for (int blk = 0; blk < GB; ++blk) {
        f32x4 a = {0.f, 0.f, 0.f, 0.f};
        if ((blk & 3) == 0) asm volatile("" ::: "memory");
        if (blk >= fb) {
          const char* kr = smem + AT_KS + (blk * 16 + fr) * 144 + fq * 16;
          const bf16x8 k0 = *(const bf16x8*)kr, k1 = *(const bf16x8*)(kr + 64);
          a = MFMA16(k0, qf[0], a); a = MFMA16(k1, qf[1], a);
        }
        s[blk] = a;
      }
      float mx = -1e30f;
#pragma unroll
      for (int blk = 0; blk < GB; ++blk) {
#pragma unroll
        for (int j = 0; j < 4; ++j) {
          float v = s[blk][j] * 0.125f;
          if (ISB) {
            if (g < 4) v += tconst;
            else v += eb[191 - ((g - 4) * 96 + blk * 16 + j)];
          }
          if (blk < fb) v = -1e30f;
          s[blk][j] = v; mx = fmaxf(mx, v);
        }
      }
      mx = fmaxf(mx, __shfl_xor(mx, 16, 64)); mx = fmaxf(mx, __shfl_xor(mx, 32, 64));
      const float m_new = fmaxf(m_run, mx);
      const float scale = __expf(m_run - m_new);
      m_run = m_new;
      float sum = 0.f;
#pragma unroll
      for (int blk = 0; blk < GB; ++blk)
#pragma unroll
        for (int j = 0; j < 4; ++j) { const float e = __expf(s[blk][j] - m_new); s[blk][j] = e; sum += e; }
      sum += __shfl_xor(sum, 16, 64); sum += __shfl_xor(sum, 32, 64);
      l_run = l_run * scale + sum;
#pragma unroll
      for (int d = 0; d < 4; ++d) { o[d][0] *= scale; o[d][1] *= scale; o[d][2] *= scale; o[d][3] *= scale; }
#pragma unroll
      for (int pp = 0; pp < GB / 2; ++pp) {
        if ((pp & 1) == 0) asm volatile("" ::: "memory");
        if (2 * pp >= fb) {
          uint4 pk = make_uint4(pack2(s[2 * pp][0], s[2 * pp][1]), pack2(s[2 * pp][2], s[2 * pp][3]),
                                pack2(s[2 * pp + 1][0], s[2 * pp + 1][1]), pack2(s[2 * pp + 1][2], s[2 * pp + 1][3]));
          const bf16x8 pb = __builtin_bit_cast(bf16x8, pk);
#pragma unroll
          for (int d = 0; d < 4; ++d) {
            const char* vr = smem + AT_VS + (d * 16 + fr) * VROW + (pp * 32 + fq * 4) * 2;
            const uint2 lo = *(const uint2*)vr, hi = *(const uint2*)(vr + 32);
            const bf16x8 va = __builtin_bit_cast(bf16x8, make_uint4(lo.x, lo.y, hi.x, hi.y));
            o[d] = MFMA16(va, pb, o[d]);
          }
        }
      }
      if (NQH > 1) {
        const float inv = rcpf_(l_run);
#pragma unroll
        for (int d = 0; d < 4; ++d)
          *(uint2*)(Q + (size_t)qrow * 512 + h * 64 + d * 16 + fq * 4) = make_uint2(pack2(o[d][0] * inv, o[d][1] * inv), pack2(o[d][2] * inv, o[d][3] * inv));
      }
    }
    if (g + 1 < NG) {
      __syncthreads();
      AT_STORE();
      __syncthreads();
    }
  }
#undef AT_LOAD
#undef AT_STORE
  if (NQH == 1) {
    const float inv = rcpf_(l_run);
#pragma unroll
    for (int d = 0; d < 4; ++d)
      *(uint2*)(Q + (size_t)qrow * 512 + hh * 64 + d * 16 + fq * 4) = make_uint2(pack2(o[d][0] * inv, o[d][1] * inv), pack2(o[d][2] * inv, o[d][3] * inv));
  }
}

using s16x4 = __attribute__((ext_vector_type(4))) short;
#define MFMA16K(a, b, c) __builtin_amdgcn_mfma_f32_16x16x16bf16_1k((a), (b), (c), 0, 0, 0)
DI s16x4 pack4(float a, float b, float c, float d) { return __builtin_bit_cast(s16x4, make_uint2(pack2(a, b), pack2(c, d))); }
constexpr int QDS = 132, KTS = 24;
template <bool OUT>
DI void hgrn_item(const Params& p, int l, int cidx, int h, char* smem) {
  const int tid = tidx(), lane = tid & 63, wid = tid >> 6, fr = lane & 15, fq = lane >> 4;
  const int kcol = tid & 127, half = tid >> 7;
  unsigned char* ws = p.ws;
  u16* QD = (u16*)smem;
  u16* KP = QD + 16 * QDS;
  u16* KDT = KP + 16 * QDS;
  u16* VT = KDT + 128 * KTS;
  float* dec = (float*)(VT + 128 * KTS);
  float* tot = dec + 128;
  float* ssum = tot + 256;
  const u16* Hf = (const u16*)(ws + OFF_HF); const u16* Hi = (const u16*)(ws + OFF_HI);
  u16* Hq = (u16*)(ws + OFF_HQ); const u16* Hog = (const u16*)(ws + OFF_HOG);
  const bool sample = OUT && cidx >= 128;
  const int tok_base = sample ? TP + (cidx - 128) * 64 : cidx * 128;
  const int nsb = sample ? 4 : 8;
  float lb = 0.f;
  if (l == 1) lb = sigmoidf_(p.in[12][512 + h * 128 + kcol] - p.in[12][h * 128 + kcol]);
  f32x4 S[8][2];
  if (OUT) {
    const float* s0 = sample ? p.in[6] + ((size_t)(l * 8 + (cidx - 128)) * 4 + h) * 16384
                             : (const float*)(ws + OFF_ST) + ((size_t)cidx * 4 + h) * 16384;
    const float* ps = s0 + (size_t)(fq * 4) * 128 + wid * 32 + fr;
#pragma unroll
    for (int kb = 0; kb < 8; ++kb) {
      asm volatile("" : "+v"(ps));
#pragma unroll
      for (int vb = 0; vb < 2; ++vb)
#pragma unroll
        for (int i = 0; i < 4; ++i) S[kb][vb][i] = ps[i * 128 + vb * 16];
      ps += 16 * 128;
    }
  } else {
#pragma unroll
    for (int kb = 0; kb < 8; ++kb)
#pragma unroll
      for (int vb = 0; vb < 2; ++vb) S[kb][vb] = f32x4{0.f, 0.f, 0.f, 0.f};
  }
  float lastsum = 0.f;
  u16 nf[8], nq[8], ni[8];
  {
    const size_t off0 = (size_t)(tok_base + half * 8) * 512 + h * 128 + kcol;
#pragma unroll
    for (int i = 0; i < 8; ++i) { nf[i] = Hf[off0 + (size_t)i * 512]; ni[i] = Hi[off0 + (size_t)i * 512]; nq[i] = OUT ? Hq[off0 + (size_t)i * 512] : (u16)0; }
  }
#pragma unroll 1
  for (int sb = 0; sb < nsb; ++sb) {
    const int tok0 = tok_base + sb * 16;
    __syncthreads();
    float lf[8], kk8[8], q8[8], vv[8];
    float zf[8], qf_[8];
#pragma unroll
    for (int i = 0; i < 8; ++i) { zf[i] = bf2f(nf[i]); qf_[i] = bf2f(nq[i]); vv[i] = bf2f(ni[i]); }
    if (sb + 1 < nsb) {
      const size_t off0 = (size_t)(tok0 + 16 + half * 8) * 512 + h * 128 + kcol;
#pragma unroll
      for (int i = 0; i < 8; ++i) { nf[i] = Hf[off0 + (size_t)i * 512]; ni[i] = Hi[off0 + (size_t)i * 512]; if (OUT) nq[i] = Hq[off0 + (size_t)i * 512]; }
    }
    __builtin_amdgcn_sched_barrier(0);
    {
      float run = 0.f;
#pragma unroll
      for (int i = 0; i < 8; ++i) {
        const float z = zf[i];
        const float e = __expf(-fabsf(z));
        const float sp = rcpf_(1.f + e);
        const float sig = z >= 0.f ? sp : e * sp;
        const float nsig = z >= 0.f ? e * sp : sp;
        float lfi;
        if (lb > 0.f) lfi = __logf(lb + (1.f - lb) * sig);
        else lfi = fminf(z, 0.f) - __logf(1.f + e);
        run += lfi; lf[i] = run;
        kk8[i] = (1.f - lb) * nsig;
        if (OUT) { const float qp = qf_[i]; q8[i] = qp * sigmoidf_(qp); } else q8[i] = 0.f;
      }
      tot[half * 128 + kcol] = run;
    }
    __syncthreads();
    {
      const float t0 = tot[kcol], t1 = tot[128 + kcol];
      const float last = t0 + t1, base = half ? t0 : 0.f;
      float kd[8];
#pragma unroll
      for (int i = 0; i < 8; ++i) {
        const float cum = base + lf[i];
        kd[i] = kk8[i] * __expf(last - cum);
        if (OUT) {
          QD[(half * 8 + i) * QDS + kcol] = f2bf(q8[i] * __expf(cum));
          KP[(half * 8 + i) * QDS + kcol] = f2bf(kk8[i] * __expf(fminf(-cum, 80.f)));
        }
      }
      *(uint4*)(KDT + kcol * KTS + half * 8) = make_uint4(pack2(kd[0], kd[1]), pack2(kd[2], kd[3]), pack2(kd[4], kd[5]), pack2(kd[6], kd[7]));
      *(uint4*)(VT + kcol * KTS + half * 8) = make_uint4(pack2(vv[0], vv[1]), pack2(vv[2], vv[3]), pack2(vv[4], vv[5]), pack2(vv[6], vv[7]));
      if (half == 0) dec[kcol] = __expf(last);
      lastsum += last;
    }
    __syncthreads();
    s16x4 vtf[2];
#pragma unroll
    for (int vb = 0; vb < 2; ++vb) vtf[vb] = *(const s16x4*)(VT + (wid * 32 + vb * 16 + fr) * KTS + fq * 4);
    if (OUT) {
      uint2 ogp[2]; float4 cn4[2];
#pragma unroll
      for (int vb = 0; vb < 2; ++vb) {
        const int vcol = h * 128 + wid * 32 + vb * 16 + fq * 4;
        ogp[vb] = *(const uint2*)(Hog + (size_t)(tok0 + fr) * 512 + vcol);
        cn4[vb] = *(const float4*)(p.in[13] + l * 512 + vcol);
      }
      __builtin_amdgcn_sched_barrier(0);
      s16x4 qdf[8];
#pragma unroll
      for (int kb = 0; kb < 8; ++kb) qdf[kb] = *(const s16x4*)(QD + fr * QDS + kb * 16 + fq * 4);
      f32x4 at = {0.f, 0.f, 0.f, 0.f};
#pragma unroll
      for (int kb = 0; kb < 8; ++kb) { const s16x4 kpf = *(const s16x4*)(KP + fr * QDS + kb * 16 + fq * 4); at = MFMA16K(kpf, qdf[kb], at); }
#pragma unroll
      for (int i = 0; i < 4; ++i) if (fq * 4 + i > fr) at[i] = 0.f;
      const s16x4 atb = pack4(at[0], at[1], at[2], at[3]);
      f32x4 ot[2];
#pragma unroll
      for (int vb = 0; vb < 2; ++vb) {
        f32x4 o = {0.f, 0.f, 0.f, 0.f};
#pragma unroll
        for (int kb = 0; kb < 8; ++kb) o = MFMA16K(pack4(S[kb][vb][0], S[kb][vb][1], S[kb][vb][2], S[kb][vb][3]), qdf[kb], o);
        o = MFMA16K(vtf[vb], atb, o);
        ot[vb] = o;
      }
      float ss = 0.f;
#pragma unroll
      for (int vb = 0; vb < 2; ++vb)
#pragma unroll
        for (int i = 0; i < 4; ++i) ss += ot[vb][i] * ot[vb][i];
      ss += __shfl_xor(ss, 16, 64); ss += __shfl_xor(ss, 32, 64);
      if (fq == 0) ssum[wid * 16 + fr] = ss;
      __syncthreads();
      const float rn = rsqrtf((ssum[fr] + ssum[16 + fr] + ssum[32 + fr] + ssum[48 + fr]) * (1.f / 128.f) + EPS);
#pragma unroll
      for (int vb = 0; vb < 2; ++vb) {
        const int vcol = h * 128 + wid * 32 + vb * 16 + fq * 4;
        const size_t off = (size_t)(tok0 + fr) * 512 + vcol;
        const float4 cn = cn4[vb];
        const float g0 = lo_f(ogp[vb].x), g1 = hi_f(ogp[vb].x), g2 = lo_f(ogp[vb].y), g3 = hi_f(ogp[vb].y);
        *(uint2*)(Hq + off) = make_uint2(pack2(ot[vb][0] * rn * cn.x * (g0 * sigmoidf_(g0)), ot[vb][1] * rn * cn.y * (g1 * sigmoidf_(g1))),
                                         pack2(ot[vb][2] * rn * cn.z * (g2 * sigmoidf_(g2)), ot[vb][3] * rn * cn.w * (g3 * sigmoidf_(g3))));
      }
    }
#pragma unroll
    for (int kb = 0; kb < 8; ++kb) {
      const float4 d4 = *(const float4*)(dec + kb * 16 + fq * 4);
      const s16x4 kdf = *(const s16x4*)(KDT + (kb * 16 + fr) * KTS + fq * 4);
#pragma unroll
      for (int vb = 0; vb < 2; ++vb) {
        f32x4 t = S[kb][vb];
        t[0] *= d4.x; t[1] *= d4.y; t[2] *= d4.z; t[3] *= d4.w;
        S[kb][vb] = MFMA16K(kdf, vtf[vb], t);
      }
    }
  }
  if (!OUT || sample) {
    float* D = OUT ? p.out + O_CS + ((size_t)(l * 8 + (cidx - 128)) * 4 + h) * 16384
                   : (float*)(ws + OFF_ST) + ((size_t)cidx * 4 + h) * 16384;
    float* pd = D + (size_t)(fq * 4) * 128 + wid * 32 + fr;
#pragma unroll
    for (int kb = 0; kb < 8; ++kb) {
      asm volatile("" : "+v"(pd));
#pragma unroll
      for (int vb = 0; vb < 2; ++vb)
#pragma unroll
        for (int i = 0; i < 4; ++i) pd[i * 128 + vb * 16] = S[kb][vb][i];
      pd += 16 * 128;
    }
    if (!OUT && half == 0) ((float*)(ws + OFF_DECAY))[((size_t)cidx * 4 + h) * 128 + kcol] = __expf(lastsum);
  }
  __syncthreads();
}

DI void hgrn_scan(const Params& p, int l) {
  float* ST = (float*)(p.ws + OFF_ST); const float* DEC = (const float*)(p.ws + OFF_DECAY);
  for (int e = blockIdx.x * NT + tidx(); e < 65536; e += gridDim.x * NT) {
    const int h = e >> 14, k = (e >> 7) & 127;
    float S = 0.f;
    float* ptr = ST + (size_t)h * 16384 + (e & 16383);
    const float* dp = DEC + h * 128 + k;
#pragma unroll 1
    for (int c0 = 0; c0 < 128; c0 += 16) {
      float d[16], dc[16];
#pragma unroll
      for (int i = 0; i < 16; ++i) { d[i] = ptr[(size_t)(c0 + i) * 65536]; dc[i] = dp[(c0 + i) * 512]; }
#pragma unroll
      for (int i = 0; i < 16; ++i) { ptr[(size_t)(c0 + i) * 65536] = S; S = dc[i] * S + d[i]; }
    }
    p.out[O_CP + (size_t)l * 65536 + e] = S;
  }
}

template <int NB>
DI void p5_tile(const Params& p, int l, int rt, int c0, char* smem) {
  const int tid = tidx(), lane = tid & 63, wid = tid >> 6, wr = wid >> 1, fq = lane >> 4;
  unsigned char* ws = p.ws;
  float* Ct = (float*)smem; float* rs = (float*)(smem + 73728);
  const float* rowsq1 = (const float*)(ws + OFF_ROWSQ1);
  const int row0 = rt * 128;
  __syncthreads();
  if (tid < 128) rs[tid] = rsqrtf(rowsq1[row0 + tid] * (1.f / 1024.f) + EPS);
  uint2 mixp[4][NB];
#pragma unroll
  for (int m = 0; m < 4; ++m)
#pragma unroll
    for (int n = 0; n < NB; ++n) mixp[m][n] = make_uint2(0u, 0u);
#pragma unroll 1
  for (int br = 0; br < 3; ++br) {
    f32x4 acc[4][NB];
    gemm_tile<NB>(acc, (const u16*)(ws + OFF_XB), LDX, row0, 0, T, (const u16*)(ws + OFF_WIN) + (size_t)(NIN1 + br * 1024 + c0) * LDW1, LDW1, 1024, smem);
    unsigned sg[4][NB];
#pragma unroll
    for (int m = 0; m < 4; ++m) {
      const float4 r4 = *(const float4*)(rs + wr * 64 + m * 16 + fq * 4);
#pragma unroll
      for (int n = 0; n < NB; ++n) {
        const unsigned q0 = (unsigned)(sigmoidf_(acc[m][n][0] * r4.x) * 255.f + 0.5f), q1 = (unsigned)(sigmoidf_(acc[m][n][1] * r4.y) * 255.f + 0.5f);
        const unsigned q2 = (unsigned)(sigmoidf_(acc[m][n][2] * r4.z) * 255.f + 0.5f), q3 = (unsigned)(sigmoidf_(acc[m][n][3] * r4.w) * 255.f + 0.5f);
        unsigned w_ = q0 | (q1 << 8) | (q2 << 16) | (q3 << 24);
        asm volatile("" : "+v"(w_));
        sg[m][n] = w_;
      }
    }
    const u16* Ob = (const u16*)(ws + (br == 0 ? OFF_QA : (br == 1 ? OFF_QB : OFF_HQ)));
    gemm_tile<NB>(acc, Ob, 512, row0, 0, T, (const u16*)(ws + OFF_WA + br * W_BR_B) + (size_t)c0 * LDW5, LDW5, 512, smem);
#pragma unroll
    for (int m = 0; m < 4; ++m)
#pragma unroll
      for (int n = 0; n < NB; ++n) {
        const uint2 prev = mixp[m][n];
        const unsigned w = sg[m][n];
        const float k255 = 1.f / 255.f;
        const float m0 = lo_f(prev.x) + (float)(w & 255u) * k255 * acc[m][n][0], m1 = hi_f(prev.x) + (float)((w >> 8) & 255u) * k255 * acc[m][n][1];
        const float m2 = lo_f(prev.y) + (float)((w >> 16) & 255u) * k255 * acc[m][n][2], m3 = hi_f(prev.y) + (float)(w >> 24) * k255 * acc[m][n][3];
        unsigned px = pack2(m0, m1), py = pack2(m2, m3);
        asm volatile("" : "+v"(px), "+v"(py));
        mixp[m][n] = make_uint2(px, py);
      }
  }
  {
    f32x4 mix[4][NB];
#pragma unroll
    for (int m = 0; m < 4; ++m)
#pragma unroll
      for (int n = 0; n < NB; ++n) { const uint2 q = mixp[m][n]; mix[m][n] = f32x4{lo_f(q.x), hi_f(q.x), lo_f(q.y), hi_f(q.y)}; }
    acc_to_lds<NB>(mix, Ct, nullptr);
  }
  u16* mixb = (u16*)(ws + OFF_MIX);
#pragma unroll 1
  for (int i = 0; i < NB; ++i) {
    const int item = tid + NT * i; const int r = item / (NB * 2), g = item % (NB * 2);
    float v[16];
#pragma unroll
    for (int q = 0; q < 4; ++q) { const float4 t4 = *(const float4*)(Ct + r * CTS + g * 16 + q * 4); v[q * 4] = t4.x; v[q * 4 + 1] = t4.y; v[q * 4 + 2] = t4.z; v[q * 4 + 3] = t4.w; }
    u16* d = mixb + (size_t)(row0 + r) * LDX + c0 + g * 16;
    *(uint4*)d = make_uint4(pack2(v[0], v[1]), pack2(v[2], v[3]), pack2(v[4], v[5]), pack2(v[6], v[7]));
    *(uint4*)(d + 8) = make_uint4(pack2(v[8], v[9]), pack2(v[10], v[11]), pack2(v[12], v[13]), pack2(v[14], v[15]));
  }
  __syncthreads();
}

template <int NB>
DI void resid_tile(const Params& p, const u16* A, int lda, const u16* W, int ldw, int K, float* rowsq, int rt, int c0, char* smem) {
  const int tid = tidx();
  float* Ct = (float*)smem;
  const int row0 = rt * 128;
  constexpr int NGRP = NB * 2;
  f32x4 acc[4][NB];
  gemm_tile<NB>(acc, A, lda, row0, 0, T, W + (size_t)c0 * ldw, ldw, K, smem);
  acc_to_lds<NB>(acc, Ct, nullptr);
  float* x = p.out; u16* xb = (u16*)(p.ws + OFF_XB);
#pragma unroll
  for (int i = 0; i < NB; ++i) {
    const int item = tid + NT * i; const int r = item / NGRP, g = item % NGRP;
    float* xp = x + (size_t)(row0 + r) * 1024 + c0 + g * 16;
    float v[16]; float ss = 0.f;
#pragma unroll
    for (int q = 0; q < 4; ++q) {
      const float4 t4 = *(const float4*)(Ct + r * CTS + g * 16 + q * 4); float4 x4 = *(const float4*)(xp + q * 4);
      x4.x += t4.x; x4.y += t4.y; x4.z += t4.z; x4.w += t4.w;
      *(float4*)(xp + q * 4) = x4;
      v[q * 4] = x4.x; v[q * 4 + 1] = x4.y; v[q * 4 + 2] = x4.z; v[q * 4 + 3] = x4.w;
      ss += x4.x * x4.x + x4.y * x4.y + x4.z * x4.z + x4.w * x4.w;
    }
    u16* d = xb + (size_t)(row0 + r) * LDX + c0 + g * 16;
    *(uint4*)d = make_uint4(pack2(v[0], v[1]), pack2(v[2], v[3]), pack2(v[4], v[5]), pack2(v[6], v[7]));
    *(uint4*)(d + 8) = make_uint4(pack2(v[8], v[9]), pack2(v[10], v[11]), pack2(v[12], v[13]), pack2(v[14], v[15]));
    ss += __shfl_xor(ss, 1, 64);
    if (NGRP > 2) { ss += __shfl_xor(ss, 2, 64); ss += __shfl_xor(ss, 4, 64); }
    if (g == 0) atomicAdd(rowsq + row0 + r, ss);
  }
  __syncthreads();
}

DI float gelu_tanh(float g) { const float u = 0.7978845608028654f * (g + 0.044715f * g * g * g); return g * rcpf_(1.f + __expf(-2.f * u)); }
DI void p7_tile(const Params& p, int l, int rt, int ct, char* smem) {
  const int tid = tidx();
  unsigned char* ws = p.ws;
  float* Ct = (float*)smem; float* rs = (float*)(smem + 73728);
  const float* rowsq2 = (const float*)(ws + OFF_ROWSQ2);
  const bool sample = rt >= 131;
  const int base = sample ? TP + (rt - 131) * 128 : rt * 126 - 2;
  const int lo = sample ? TP : 0, hi = sample ? T : TP;
  __syncthreads();
  if (tid < 128) { const int g = base + tid; rs[tid] = (g >= lo && g < hi) ? rsqrtf(rowsq2[g] * (1.f / 1024.f) + EPS) : 0.f; }
  const float* wconv = p.in[20] + (size_t)l * 3 * DFF2; const float* bconv = p.in[21] + (size_t)l * DFF2;
  const float* cstate = p.in[7] + (size_t)l * 8 * 2 * DFF2;
  u16* act = (u16*)(ws + OFF_ACT);
  const int jp = tid & 31;
  float cw[4][4];
#pragma unroll
  for (int q = 0; q < 2; ++q)
#pragma unroll
    for (int ug = 0; ug < 2; ++ug) {
      const int oc = ug * DFF + ct * 64 + jp * 2 + q;
      cw[q * 2 + ug][0] = bconv[oc]; cw[q * 2 + ug][1] = wconv[oc]; cw[q * 2 + ug][2] = wconv[DFF2 + oc]; cw[q * 2 + ug][3] = wconv[2 * DFF2 + oc];
    }
  f32x4 acc[4][4];
  gemm_tile<4>(acc, (const u16*)(ws + OFF_XB), LDX, base, lo, hi, (const u16*)(ws + OFF_WUP) + (size_t)ct * 128 * LDW1, LDW1, 1024, smem);
  acc_to_lds<4>(acc, Ct, rs);
  const int rbase = (tid >> 5) * 16;
  float w1[4], w0[4];
#pragma unroll
  for (int c = 0; c < 4; ++c) {
    const int lc = jp * 2 + (c >> 1) + (c & 1) * 64;
    w1[c] = rbase >= 1 ? Ct[(rbase - 1) * CTS + lc] : 0.f;
    w0[c] = rbase >= 2 ? Ct[(rbase - 2) * CTS + lc] : 0.f;
  }
#pragma unroll 4
  for (int i = 0; i < 16; ++i) {
    const int r = rbase + i;
    const int tok = base + r;
    bool valid; int bi = 0, ti = 2;
    if (sample) { valid = true; bi = (tok - TP) >> 6; ti = (tok - TP) & 63; }
    else valid = (r >= 2) && (tok < TP);
    float cv[4], u2v[4];
#pragma unroll
    for (int c = 0; c < 4; ++c) {
      const int q = c >> 1, ug = c & 1;
      const int jc = jp * 2 + q;
      const int lc = jc + ug * 64;
      const int oc = ug * DFF + ct * 64 + jc;
      const float u2 = Ct[r * CTS + lc];
      float u1 = w1[c], u0 = w0[c];
      if (sample && ti < 2) { u1 = (ti >= 1) ? u1 : cstate[((size_t)bi * 2 + 1) * DFF2 + oc]; u0 = cstate[((size_t)bi * 2 + ti) * DFF2 + oc]; }
      cv[c] = cw[c][0] + cw[c][1] * u0 + cw[c][2] * u1 + cw[c][3] * u2;
      u2v[c] = u2; w0[c] = w1[c]; w1[c] = u2;
      if (valid) {
        if (!sample) { if (tok >= TP - 2) p.out[O_CVP + ((size_t)l * 2 + (tok - (TP - 2))) * DFF2 + oc] = u2; }
        else if (ti >= 62) p.out[O_CVS + (((size_t)l * 8 + bi) * 2 + (ti - 62)) * DFF2 + oc] = u2;
      }
    }
    if (valid) *(unsigned*)(act + (size_t)tok * LDACT + ct * 64 + jp * 2) = pack2(cv[0] * gelu_tanh(cv[1]), cv[2] * gelu_tanh(cv[3]));
  }
  __syncthreads();
}

DI void final_norm(const Params& p) {
  const int lane = tidx() & 63, wid = tidx() >> 6;
  const float* rowsq1 = (const float*)(p.ws + OFF_ROWSQ1);
  for (int it = blockIdx.x; it < T / 4; it += gridDim.x) {
    const int row = it * 4 + wid;
    const float rstd = rsqrtf(rowsq1[row] * (1.f / 1024.f) + EPS);
#pragma unroll
    for (int i = 0; i < 4; ++i) {
      const int c = (i * 64 + lane) * 4;
      float4 v = *(float4*)(p.out + (size_t)row * 1024 + c);
      const float4 g = *(const float4*)(p.in[23] + c);
      v.x *= rstd * g.x; v.y *= rstd * g.y; v.z *= rstd * g.z; v.w *= rstd * g.w;
      *(float4*)(p.out + (size_t)row * 1024 + c) = v;
    }
  }
}

DI int vblock(int b, int G) { const int nper = G >> 3; return (G & 7) ? b : ((b & 7) * nper + (b >> 3)); }
DI void tile_map(int j, int nrt, int nct, int& rt, int& ct) {
  constexpr int GR = TILE_GR;
  const int gw = GR * nct; const int g = j / gw, w = j - g * gw; const int gsz = min(GR, nrt - GR * g);
  ct = w / gsz; rt = GR * g + (w - ct * gsz);
}

__global__ void __launch_bounds__(NT, 2) fwd_megakernel(Params p) {
  extern __shared__ __attribute__((aligned(16))) char smem[];
  cg::grid_group grid = cg::this_grid();
#if USE_CG_SYNC
#define GSYNC() grid.sync()
#else
  __shared__ uint4 xb_words;
  if (threadIdx.x == 0) xb_words = make_uint4(0u, 0u, 0u, 0u);
  __syncthreads();
  XcdBarrier xb = xcd_barrier_post((unsigned*)(p.ws + OFF_BAR), (volatile LAS unsigned*)&xb_words);
  if (gridDim.y == 12345u) grid.sync();
#define GSYNC() xcd_barrier(xb)
#endif
  const int G = gridDim.x, bid = blockIdx.x;
  int vb = vblock(bid, G);
  int rt_, ct_;
  unsigned long long tacc = 0, tmark = 0;
#define TBEG(id) do { if (TPROBE == (id)) tmark = __builtin_amdgcn_s_memrealtime(); } while (0)
#define TEND(id) do { if (TPROBE == (id)) tacc += __builtin_amdgcn_s_memrealtime() - tmark; } while (0)
  unsigned char* ws = p.ws;
  TBEG(9); if (PHM & 1) phase0(p, smem);
  GSYNC(); TEND(9);
#if !USE_CG_SYNC
  {
    unsigned* bar = (unsigned*)(p.ws + OFF_BAR);
    bool even = (G & 7) == 0;
    for (int j = 0; j < 16; ++j) { const unsigned c = xb_ld(&bar[XB_XCNT(j)]); even = even && (c == (j < 8 ? (unsigned)(G >> 3) : 0u)); }
    if (even) vb = (int)xb.x * (G >> 3) + (int)xb_words.z;
  }
#endif
  for (int l = 0; l < 2; ++l) {
    TBEG(1);
    if (PHM & 2) cache_to_kv(p, l);
    for (int rep = 0; rep < ((DBL & 1) ? 2 : 1); ++rep)
    if (PHM & 2) for (int it = vb; it < 132 * 34; it += G) { tile_map(it, 132, 34, rt_, ct_); p1_tile(p, l, rt_, ct_, smem); }
    { float* rq2 = (float*)(ws + OFF_ROWSQ2); for (int i = bid * NT + threadIdx.x; i < T; i += G * NT) rq2[i] = 0.f; }
    GSYNC(); TEND(1);
    TBEG(2);
    for (int it = bid; it < 264 * 8 + 512 + 264 * 2 + 32; it += G) {
      if (it < 2112) { if (PHM & 4) attn_item<true>(p, l, it >> 3, it & 7, smem); }
      else if (it < 2624) { const int j = it - 2112; if (PHM & 8) hgrn_item<false>(p, l, j >> 2, j & 3, smem); }
      else if (it < 3152) { const int j = it - 2624; if (PHM & 16) attn_item<false>(p, l, j >> 1, j & 1, smem); }
      else { const int j = it - 3152; hgrn_item<true>(p, l, 128 + (j >> 2), j & 3, smem); }
    }
    GSYNC(); TEND(2);
    TBEG(3);
    if (PHM & 32) hgrn_scan(p, l);
    GSYNC(); TEND(3);
    TBEG(4);
    if (PHM & 64) for (int it = bid; it < 128 * 4; it += G) hgrn_item<true>(p, l, it >> 2, it & 3, smem);
    GSYNC(); TEND(4);
    TBEG(5);
    if (PHM & 128) for (int it = bid; it < NCONV_FFN; it += G) conv_wffn_item(p, l, it, smem);
    for (int rep = 0; rep < ((DBL & 2) ? 2 : 1); ++rep)
    if (PHM & 256) for (int it = vb; it < 1024 + 64; it += G) {
      if (it < 1024) { tile_map(it, 128, 8, rt_, ct_); p5_tile<4>(p, l, rt_, ct_ * 128, smem); }
      else { const int j = it - 1024; p5_tile<2>(p, l, 128 + (j >> 4), (j & 15) * 64, smem); }
    }
    GSYNC(); TEND(5);
    TBEG(6);
    { float* rq1 = (float*)(ws + OFF_ROWSQ1); for (int i = bid * NT + threadIdx.x; i < T; i += G * NT) rq1[i] = 0.f; }
    if (PHM & 512) for (int it = vb; it < 1024 + 128; it += G) {
      if (it < 1024) { tile_map(it, 128, 8, rt_, ct_);
        resid_tile<4>(p, (const u16*)(ws + OFF_MIX), LDX, (const u16*)(ws + OFF_WOUT), LDW1, 1024, (float*)(ws + OFF_ROWSQ2), rt_, ct_ * 128, smem); }
      else { const int j = it - 1024;
        resid_tile<1>(p, (const u16*)(ws + OFF_MIX), LDX, (const u16*)(ws + OFF_WOUT), LDW1, 1024, (float*)(ws + OFF_ROWSQ2), 128 + (j >> 5), (j & 31) * 32, smem); }
    }
    GSYNC(); TEND(6);
    TBEG(7);
    for (int rep = 0; rep < ((DBL & 4) ? 2 : 1); ++rep)
    if (PHM & 1024) for (int it = vb; it < 135 * 44; it += G) { tile_map(it, 135, 44, rt_, ct_); p7_tile(p, l, rt_, ct_, smem); }
    GSYNC(); TEND(7);
    TBEG(8);
    if (l == 0) for (int it = bid; it < NCONV_MIX; it += G) conv_wmix_item(p, 1, it, smem);
    if (PHM & 2048) for (int it = vb; it < 1024 + 128; it += G) {
      if (it < 1024) { tile_map(it, 128, 8, rt_, ct_);
        resid_tile<4>(p, (const u16*)(ws + OFF_ACT), LDACT, (const u16*)(ws + OFF_WDOWN), LDACT, DFF, (float*)(ws + OFF_ROWSQ1), rt_, ct_ * 128, smem); }
      else { const int j = it - 1024;
        resid_tile<1>(p, (const u16*)(ws + OFF_ACT), LDACT, (const u16*)(ws + OFF_WDOWN), LDACT, DFF, (float*)(ws + OFF_ROWSQ1), 128 + (j >> 5), (j & 31) * 32, smem); }
    }
    GSYNC(); TEND(8);
  }
  final_norm(p);
  if (TPROBE != 0 && bid == 0) { const unsigned long long t0 = __builtin_amdgcn_s_memrealtime(); while (__builtin_amdgcn_s_memrealtime() - t0 < 4 * tacc) __builtin_amdgcn_s_sleep(8); }
}

extern "C" void kernel_launch(void* const* d_in, const int* in_sizes, int n_in, void* d_out, int out_size,
                              void* d_ws, size_t ws_size, hipStream_t stream) {
  static int grid_blocks = 0;
  if (!grid_blocks) {
    int dev = 0, cus = 0, per_cu = 0;
    hipGetDevice(&dev);
    hipDeviceGetAttribute(&cus, hipDeviceAttributeMultiprocessorCount, dev);
    hipFuncSetAttribute((const void*)fwd_megakernel, hipFuncAttributeMaxDynamicSharedMemorySize, LDS_BYTES);
    hipOccupancyMaxActiveBlocksPerMultiprocessor(&per_cu, (const void*)fwd_megakernel, NT, LDS_BYTES);
    if (per_cu < 1) per_cu = 1;
    if (per_cu > 2) per_cu = 2;
    grid_blocks = cus * per_cu;
    if (grid_blocks > 512) grid_blocks = 512;
    if (ws_size < WS_END2 || (size_t)out_size < O_END || n_in < 24)
      fprintf(stderr, "kernel_launch: unexpected sizes ws=%zu need=%zu out=%d need=%zu n_in=%d\n", ws_size, (size_t)WS_END, out_size, (size_t)O_END, n_in);
  }
  Params p{};
  for (int i = 0; i < 24; ++i) p.in[i] = (const float*)d_in[i];
  p.out = (float*)d_out; p.ws = (unsigned char*)d_ws;
  hipMemsetAsync((char*)d_ws + OFF_BAR, 0, 16384, stream);
  void* args[] = {&p};
  hipError_t e = hipLaunchCooperativeKernel((const void*)fwd_megakernel, dim3(grid_blocks), dim3(NT), args, LDS_BYTES, stream);
  if (e != hipSuccess) fprintf(stderr, "cooperative launch failed: %s (grid %d)\n", hipGetErrorString(e), grid_blocks);
}
```

```cpp
#include <hip/hip_runtime.h>
#include <hip/hip_cooperative_groups.h>
#include <cstdio>
namespace cg = cooperative_groups;

typedef unsigned short u16;
using bf16x8 = __attribute__((ext_vector_type(8))) short;
using f32x4 = __attribute__((ext_vector_type(4))) float;
#define DI __device__ __forceinline__
#define MFMA16(a, b, c) __builtin_amdgcn_mfma_f32_16x16x32_bf16((a), (b), (c), 0, 0, 0)

#ifndef PHM
#define PHM 0xFFFF
#endif
#ifndef DBL
#define DBL 0
#endif
#ifndef TPROBE
#define TPROBE 0
#endif
#ifndef TILE_GR
#define TILE_GR 8
#endif
#ifndef USE_CG_SYNC
#define USE_CG_SYNC 0
#endif

constexpr int DM = 1024, TP = 16384, TS = 512, T = TP + TS, NBATCH = 8;
constexpr int INW = 7424, NIN1 = 4352;
constexpr int DFF = 2816, DFF2 = 5632;
constexpr int KA_ROWS = TP + NBATCH * 192, KB_ROWS = TP + NBATCH * 576;
constexpr int NT = 256;
constexpr float EPS = 1e-6f;
constexpr int LDX = 1088, LDW1 = 1088, LDW5 = 576, LDACT = 2880;
constexpr int LDS_BYTES = 73728 + 1024;

constexpr size_t OFF_BAR   = 0;
constexpr size_t OFF_ROWSQ1 = 16384;
constexpr size_t OFF_ROWSQ2 = OFF_ROWSQ1 + 67584;
constexpr size_t OFF_DECAY = OFF_ROWSQ2 + 67584;
constexpr size_t OFF_WMIX  = OFF_DECAY + 262144;
constexpr size_t W_IN_B = (size_t)INW * LDW1 * 2, W_BR_B = (size_t)1024 * LDW5 * 2, W_OUT_B = (size_t)1024 * LDW1 * 2;
constexpr size_t OFF_WIN = OFF_WMIX, OFF_WA = OFF_WIN + W_IN_B, OFF_WB = OFF_WA + W_BR_B, OFF_WC = OFF_WB + W_BR_B, OFF_WOUT = OFF_WC + W_BR_B;
constexpr size_t OFF_XB    = OFF_WOUT + W_OUT_B;
constexpr size_t OFF_ST    = OFF_XB + (size_t)T * LDX * 2;
constexpr size_t OFF_WUP = OFF_ST, OFF_WDOWN = OFF_ST + (size_t)DFF2 * LDW1 * 2;
static_assert(OFF_WDOWN + (size_t)1024 * LDACT * 2 <= OFF_ST + (size_t)128 * 4 * 16384 * 4, "ffn weights fit the state region");
constexpr size_t OFF_QA    = OFF_ST + (size_t)128 * 4 * 16384 * 4;
constexpr size_t PLANE = (size_t)T * 512 * 2;
constexpr size_t OFF_QB    = OFF_QA + PLANE;
constexpr size_t OFF_KA    = OFF_QB + PLANE;
constexpr size_t OFF_VTA   = OFF_KA + (size_t)KA_ROWS * 128 * 2;
constexpr size_t OFF_KB    = OFF_VTA + (size_t)KA_ROWS * 128 * 2;
constexpr size_t OFF_VTB   = OFF_KB + (size_t)KB_ROWS * 512 * 2;
constexpr size_t OFF_HF    = OFF_VTB + (size_t)KB_ROWS * 512 * 2;
constexpr size_t OFF_HI = OFF_HF + PLANE, OFF_HQ = OFF_HI + PLANE, OFF_HOG = OFF_HQ + PLANE;
constexpr size_t WS_END = OFF_HOG + PLANE;
constexpr size_t OFF_P5S = WS_END;
constexpr size_t WS_END2 = OFF_P5S + (size_t)512 * 32768;
static_assert(WS_END2 <= (size_t)256 * 1024 * 1024, "workspace budget");
constexpr size_t OFF_MIX = OFF_KB;
static_assert((size_t)T * LDX * 2 <= 2 * (size_t)KB_ROWS * 512 * 2, "mix fits");
constexpr size_t OFF_ACT = OFF_QA;
static_assert(OFF_ACT + (size_t)T * LDACT * 2 <= OFF_HQ, "act fits");

constexpr size_t O_X = 0;
constexpr size_t O_AKP = (size_t)T * 1024;
constexpr size_t O_AVP = O_AKP + 32768;
constexpr size_t O_BKP = O_AVP + 32768;
constexpr size_t O_BVP = O_BKP + 524288;
constexpr size_t O_CP  = O_BVP + 524288;
constexpr size_t O_CVP = O_CP + 131072;
constexpr size_t O_AKS = O_CVP + 22528;
constexpr size_t O_AVS = O_AKS + 262144;
constexpr size_t O_BKS = O_AVS + 262144;
constexpr size_t O_BVS = O_BKS + 4194304;
constexpr size_t O_CS  = O_BVS + 4194304;
constexpr size_t O_CVS = O_CS + 1048576;
constexpr size_t O_END = O_CVS + 180224;

struct Params { const float* in[24]; float* out; unsigned char* ws; };

DI u16 f2bf(float x) { unsigned u = __float_as_uint(x); u += 0x7fffu + ((u >> 16) & 1u); return (u16)(u >> 16); }
DI float bf2f(u16 v) { return __uint_as_float(((unsigned)v) << 16); }
typedef __bf16 bf16x2_t __attribute__((ext_vector_type(2)));
DI unsigned pack2(float a, float b) { bf16x2_t v = {(__bf16)a, (__bf16)b}; return __builtin_bit_cast(unsigned, v); }
DI float lo_f(unsigned u) { return __uint_as_float(u << 16); }
DI float hi_f(unsigned u) { return __uint_as_float(u & 0xffff0000u); }
DI float wave_sum(float v) {
#pragma unroll
  for (int o = 32; o >= 1; o >>= 1) v += __shfl_xor(v, o, 64);
  return v;
}
DI int tidx() { int t = threadIdx.x; asm volatile("" : "+v"(t)); return t; }
DI float rcpf_(float x) { return __builtin_amdgcn_rcpf(x); }
DI float sigmoidf_(float x) { return rcpf_(1.f + __expf(-x)); }
DI int krowA(int tok) { if (tok < TP) return tok; int s = tok - TP; return TP + (s >> 6) * 192 + 128 + (s & 63); }
DI int krowB(int tok) { if (tok < TP) return tok; int s = tok - TP; return TP + (s >> 6) * 576 + 512 + (s & 63); }

#define XB_TMO      128
#define XB_XCNT(j)  (256  + 64 * (j))
#define XB_XSUB(j)  (1280 + 64 * (j))
#define XB_XGEN(j)  (2304 + 64 * (j))
#define XB_TOP      3328
#define XB_TOPGEN   3392
#define XCD_BAR_WORDS 3456
#define XB_SPIN_CAP (1u << 24)
#define LAS __attribute__((address_space(3)))
DI unsigned xb_ld(unsigned* p) { return __hip_atomic_load(p, __ATOMIC_RELAXED, __HIP_MEMORY_SCOPE_AGENT); }
DI unsigned xb_add(unsigned* p, unsigned v) { return __hip_atomic_fetch_add(p, v, __ATOMIC_RELAXED, __HIP_MEMORY_SCOPE_AGENT); }
DI unsigned xb_xcc_id() { return (unsigned)__builtin_amdgcn_s_getreg((3 << 11) | 20) & 0xFu; }
#define XB_SPIN(cond, bar) do { unsigned _sp = 0; while (cond) { __builtin_amdgcn_s_sleep(1); \
    if ((++_sp & 255u) == 0u) { if (xb_ld(&(bar)[XB_TMO])) break; if (_sp > XB_SPIN_CAP) { atomicAdd(&(bar)[XB_TMO], 1u); break; } } } } while (0)
struct XcdBarrier { unsigned* bar; unsigned x; volatile LAS unsigned* st; };
DI XcdBarrier xcd_barrier_post(unsigned* bar, volatile LAS unsigned* st) {
  XcdBarrier b; b.bar = bar; b.x = xb_xcc_id(); b.st = st;
  if (threadIdx.x == 0) st[2] = xb_add(&bar[XB_XCNT(b.x)], 1u);
  return b;
}
DI void xcd_barrier_complete(unsigned* bar, unsigned x, unsigned& nloc, unsigned& nx) {
  const unsigned G = gridDim.x;
  unsigned sum, cnt, mine, sp = 0u;
  for (;;) {
    sum = 0u; cnt = 0u; mine = 0u;
#pragma unroll
    for (unsigned j = 0; j < 16; ++j) { const unsigned c = xb_ld(&bar[XB_XCNT(j)]); sum += c; cnt += (c > 0u) ? 1u : 0u; mine = (j == x) ? c : mine; }
    if (sum == G) break;
    __builtin_amdgcn_s_sleep(1);
    if ((++sp & 255u) == 0u) { if (xb_ld(&bar[XB_TMO])) break; if (sp > XB_SPIN_CAP) { atomicAdd(&bar[XB_TMO], 1u); break; } }
  }
  nloc = mine > 0u ? mine : 1u; nx = cnt > 0u ? cnt : 1u;
}
DI void xcd_barrier(const XcdBarrier& b) {
  asm volatile("s_waitcnt vmcnt(0)" ::: "memory");
  __syncthreads();
  if (threadIdx.x == 0) {
    unsigned* bar = b.bar;
    __builtin_amdgcn_s_waitcnt(0);
    unsigned nloc = b.st[0], nx = b.st[1];
    if (nloc == 0u) { xcd_barrier_complete(bar, b.x, nloc, nx); b.st[0] = nloc; b.st[1] = nx; }
    const unsigned old = xb_add(&bar[XB_XSUB(b.x)], 1u);
    const unsigned gen = old / nloc;
    if (old + 1u == (gen + 1u) * nloc) {
      __builtin_amdgcn_fence(__ATOMIC_RELEASE, "agent");
      asm volatile("s_waitcnt vmcnt(0)" ::: "memory");
      const unsigned og = xb_add(&bar[XB_TOP], 1u);
      const unsigned tg = og / nx;
      if (og + 1u == (tg + 1u) * nx) xb_add(&bar[XB_TOPGEN], 1u);
      else XB_SPIN(xb_ld(&bar[XB_TOPGEN]) == tg, bar);
      __builtin_amdgcn_fence(__ATOMIC_ACQUIRE, "agent");
      xb_add(&bar[XB_XGEN(b.x)], 1u);
      asm volatile("s_waitcnt vmcnt(0)" ::: "memory");
    } else {
      XB_SPIN(xb_ld(&bar[XB_XGEN(b.x)]) == gen, bar);
      __builtin_amdgcn_fence(__ATOMIC_ACQUIRE, "agent");
      asm volatile("s_waitcnt vmcnt(0)" ::: "memory");
    }
  }
  __syncthreads();
}

template <int NB>
DI void gemm_tile(f32x4 (&acc)[4][NB], const u16* __restrict__ A, int lda, int row0, int lo, int hi,
                  const u16* __restrict__ W, int ldw, int K, char* smem) {
  const int tid = tidx(), lane = tid & 63, wid = tid >> 6, wr = wid >> 1, wc = wid & 1, fr = lane & 15, fq = lane >> 4;
  const int sr = tid >> 3, sc = tid & 7;
#pragma unroll
  for (int m = 0; m < 4; ++m)
#pragma unroll
    for (int n = 0; n < NB; ++n) acc[m][n] = f32x4{0.f, 0.f, 0.f, 0.f};
  const int g0 = row0 + sr;
  const int c0r = min(max(g0, lo), hi - 1), c1r = min(max(g0 + 32, lo), hi - 1), c2r = min(max(g0 + 64, lo), hi - 1), c3r = min(max(g0 + 96, lo), hi - 1);
  const int csw = (sc ^ ((sr >> 1) & 7)) * 8;
  const u16* ap0 = A + (size_t)c0r * lda + csw;
  const u16* ap1 = A + (size_t)c1r * lda + csw;
  const u16* ap2 = A + (size_t)c2r * lda + csw;
  const u16* ap3 = A + (size_t)c3r * lda + csw;
  const u16* wp = W + (size_t)sr * ldw + csw;
  const size_t ws32 = (size_t)32 * ldw;
  int koff = 0;
  char* sdst = smem + tid * 16;
#define GLDS(g, l) __builtin_amdgcn_global_load_lds((const __attribute__((address_space(1))) unsigned*)(g), (__attribute__((address_space(3))) unsigned*)(l), 16, 0, 0)
#define STAGE(buf) do { char* d_ = sdst + (buf) * 32768; \
    GLDS(ap0 + koff, d_); GLDS(ap1 + koff, d_ + 4096); GLDS(ap2 + koff, d_ + 8192); GLDS(ap3 + koff, d_ + 12288); \
    GLDS(wp + koff, d_ + 16384); if (NB > 1) GLDS(wp + ws32 + koff, d_ + 16384 + 4096); \
    if (NB > 2) { GLDS(wp + 2 * ws32 + koff, d_ + 16384 + 8192); GLDS(wp + 3 * ws32 + koff, d_ + 16384 + 12288); } \
    koff += 64; } while (0)
  const int fsw = (fr >> 1) & 7;
  const int fa = (wr * 64 + fr) * 128, fb = 16384 + (wc * (NB * 16) + fr) * 128;
#define COMPUTE(buf) do { const char* b = smem + (buf) * 32768; \
    _Pragma("unroll") for (int kk = 0; kk < 2; ++kk) { \
      bf16x8 af[4], bfr[NB]; \
      const int co = ((kk * 4 + fq) ^ fsw) * 16; \
      _Pragma("unroll") for (int m = 0; m < 4; ++m) af[m] = *(const bf16x8*)(b + fa + m * 2048 + co); \
      _Pragma("unroll") for (int n = 0; n < NB; ++n) bfr[n] = *(const bf16x8*)(b + fb + n * 2048 + co); \
      __builtin_amdgcn_s_setprio(1); \
      _Pragma("unroll") for (int m = 0; m < 4; ++m) \
        _Pragma("unroll") for (int n = 0; n < NB; ++n) acc[m][n] = MFMA16(af[m], bfr[n], acc[m][n]); \
      __builtin_amdgcn_s_setprio(0); \
    } } while (0)
  const int nk = K >> 6;
  STAGE(0);
  asm volatile("s_waitcnt vmcnt(0)" ::: "memory");
  __syncthreads();
#pragma unroll 4
  for (int kt = 0; kt < nk; ++kt) {
    if (kt + 1 < nk) STAGE((kt + 1) & 1);
    COMPUTE(kt & 1);
    asm volatile("s_waitcnt vmcnt(0)" ::: "memory");
    __syncthreads();
  }
#undef GLDS
#undef STAGE
#undef COMPUTE
}

constexpr int CTS = 132;
template <int NB>
DI void acc_to_lds(const f32x4 (&acc)[4][NB], float* Ct, const float* rs) {
  const int tid = tidx(), lane = tid & 63, wid = tid >> 6, wr = wid >> 1, wc = wid & 1, fr = lane & 15, fq = lane >> 4;
#pragma unroll
  for (int m = 0; m < 4; ++m)
#pragma unroll
    for (int j = 0; j < 4; ++j) {
      const int r = wr * 64 + m * 16 + fq * 4 + j;
      const float s = rs ? rs[r] : 1.f;
#pragma unroll
      for (int n = 0; n < NB; ++n) Ct[r * CTS + wc * (NB * 16) + n * 16 + fr] = acc[m][n][j] * s;
    }
  __syncthreads();
}

DI void conv_wtile(const float* __restrict__ src, int K, int N, u16* __restrict__ dst, int ldk, const float* __restrict__ gain, int permute, int tile, float* tl) {
  const int tid = tidx();
  const int nnt = N >> 6; const int kt = tile / nnt, nt = tile - kt * nnt; const int k0 = kt * 64, n0 = nt * 64;
  {
    const int n = tid & 63, kq = tid >> 6;
    float v16[16];
#pragma unroll
    for (int i = 0; i < 16; ++i) v16[i] = src[(size_t)(k0 + i * 4 + kq) * N + n0 + n];
#pragma unroll
    for (int i = 0; i < 16; ++i) { const int k = i * 4 + kq; float v = v16[i]; if (gain) v *= gain[k0 + k]; tl[k * 65 + n] = v; }
  }
  __syncthreads();
#pragma unroll
  for (int j = 0; j < 2; ++j) {
    const int n = (tid >> 3) + 32 * j, ks = tid & 7;
    float v[8];
#pragma unroll
    for (int q = 0; q < 8; ++q) v[q] = tl[(ks * 8 + q) * 65 + n];
    int nn = n0 + n;
    if (permute) nn = (nn < DFF) ? ((nn >> 6) * 128 + (nn & 63)) : ((((nn - DFF) >> 6) * 128) + 64 + ((nn - DFF) & 63));
    uint4 pk = make_uint4(pack2(v[0], v[1]), pack2(v[2], v[3]), pack2(v[4], v[5]), pack2(v[6], v[7]));
    *(uint4*)(dst + (size_t)nn * ldk + k0 + ks * 8) = pk;
  }
  __syncthreads();
}
constexpr int NCONV_MIX = 1856 + 3 * 128 + 256;
constexpr int NCONV_FFN = 1408 + 704;
DI void conv_wmix_item(const Params& p, int l, int it, char* smem) {
  float* tl = (float*)smem; unsigned char* ws = p.ws;
  if (it < 1856) conv_wtile(p.in[9] + (size_t)l * 1024 * INW, 1024, INW, (u16*)(ws + OFF_WIN), LDW1, p.in[8] + l * 1024, 0, it, tl);
  else if (it < 1856 + 384) { const int b = (it - 1856) >> 7, t = (it - 1856) & 127;
    conv_wtile(p.in[14 + b] + (size_t)l * 512 * 1024, 512, 1024, (u16*)(ws + OFF_WA + b * W_BR_B), LDW5, nullptr, 0, t, tl); }
  else conv_wtile(p.in[17] + (size_t)l * 1024 * 1024, 1024, 1024, (u16*)(ws + OFF_WOUT), LDW1, nullptr, 0, it - 2240, tl);
}
DI void conv_wffn_item(const Params& p, int l, int it, char* smem) {
  float* tl = (float*)smem; unsigned char* ws = p.ws;
  if (it < 1408) conv_wtile(p.in[19] + (size_t)l * 1024 * DFF2, 1024, DFF2, (u16*)(ws + OFF_WUP), LDW1, p.in[18] + l * 1024, 1, it, tl);
  else conv_wtile(p.in[22] + (size_t)l * DFF * 1024, DFF, 1024, (u16*)(ws + OFF_WDOWN), LDACT, nullptr, 0, it - 1408, tl);
}

DI void phase0(const Params& p, char* smem) {
  const int tid = tidx(), lane = tid & 63, wid = tid >> 6;
  float* x = p.out; u16* xb = (u16*)(p.ws + OFF_XB);
  float* rowsq1 = (float*)(p.ws + OFF_ROWSQ1); float* rowsq2 = (float*)(p.ws + OFF_ROWSQ2);
  for (int it = blockIdx.x; it < T / 4; it += gridDim.x) {
    const int row = it * 4 + wid;
    const float* src = row < TP ? p.in[0] + (size_t)row * 1024 : p.in[1] + (size_t)(row - TP) * 1024;
    float ss = 0.f;
#pragma unroll
    for (int i = 0; i < 4; ++i) {
      const int c = (i * 64 + lane) * 4;
      const float4 v = *(const float4*)(src + c);
      *(float4*)(x + (size_t)row * 1024 + c) = v;
      ss += v.x * v.x + v.y * v.y + v.z * v.z + v.w * v.w;
      *(uint2*)(xb + (size_t)row * LDX + c) = make_uint2(pack2(v.x, v.y), pack2(v.z, v.w));
    }
    ss = wave_sum(ss);
    if (lane == 0) { rowsq1[row] = ss; rowsq2[row] = 0.f; }
  }
  for (int it = blockIdx.x; it < NCONV_MIX; it += gridDim.x) conv_wmix_item(p, 0, it, smem);
  const size_t gsz = (size_t)gridDim.x * NT, g0 = (size_t)blockIdx.x * NT + tid;
  for (size_t e = g0; e < (size_t)2 * 8 * 64 * 128; e += gsz) {
    const size_t lb = e / (64 * 128), r = e % (64 * 128);
    p.out[O_AKS + lb * 128 * 128 + r] = p.in[2][lb * 128 * 128 + 64 * 128 + r];
    p.out[O_AVS + lb * 128 * 128 + r] = p.in[3][lb * 128 * 128 + 64 * 128 + r];
  }
  for (size_t e = g0; e < (size_t)2 * 8 * 448 * 512 / 4; e += gsz) {
    const size_t e4 = e * 4; const size_t lb = e4 / (448 * 512), r = e4 % (448 * 512);
    *(float4*)(p.out + O_BKS + lb * 512 * 512 + r) = *(const float4*)(p.in[4] + lb * 512 * 512 + 64 * 512 + r);
    *(float4*)(p.out + O_BVS + lb * 512 * 512 + r) = *(const float4*)(p.in[5] + lb * 512 * 512 + 64 * 512 + r);
  }
}

DI void cache_to_kv(const Params& p, int l) {
  const int tid = tidx();
  const size_t gsz = (size_t)gridDim.x * NT, g0 = (size_t)blockIdx.x * NT + tid;
  u16* Ka = (u16*)(p.ws + OFF_KA); u16* Vta = (u16*)(p.ws + OFF_VTA); u16* Kb = (u16*)(p.ws + OFF_KB); u16* Vtb = (u16*)(p.ws + OFF_VTB);
  for (size_t e = g0; e < (size_t)8 * 128 * 128 / 8; e += gsz) {
    const size_t e8 = e * 8; const int b = (int)(e8 / (128 * 128)); const int j = (int)((e8 / 128) % 128), c = (int)(e8 % 128);
    const float* s = p.in[2] + ((size_t)(l * 8 + b) * 128 + j) * 128 + c;
    const float4 v0 = *(const float4*)s, v1 = *(const float4*)(s + 4);
    *(uint4*)(Ka + (size_t)(TP + b * 192 + j) * 128 + c) = make_uint4(pack2(v0.x, v0.y), pack2(v0.z, v0.w), pack2(v1.x, v1.y), pack2(v1.z, v1.w));
  }
  for (size_t e = g0; e < (size_t)8 * 512 * 512 / 8; e += gsz) {
    const size_t e8 = e * 8; const int b = (int)(e8 / (512 * 512)); const int j = (int)((e8 / 512) % 512), c = (int)(e8 % 512);
    const float* s = p.in[4] + ((size_t)(l * 8 + b) * 512 + j) * 512 + c;
    const float4 v0 = *(const float4*)s, v1 = *(const float4*)(s + 4);
    *(uint4*)(Kb + (size_t)(TP + b * 576 + j) * 512 + c) = make_uint4(pack2(v0.x, v0.y), pack2(v0.z, v0.w), pack2(v1.x, v1.y), pack2(v1.z, v1.w));
  }
  for (size_t e = g0; e < (size_t)8 * 16 * 128; e += gsz) {
    const int c = (int)(e % 128), j8 = (int)((e / 128) % 16), b = (int)(e / (128 * 16));
    const float* s = p.in[3] + ((size_t)(l * 8 + b) * 128 + j8 * 8) * 128 + c;
    float v[8];
#pragma unroll
    for (int q = 0; q < 8; ++q) v[q] = s[(size_t)q * 128];
    *(uint4*)(Vta + (size_t)c * KA_ROWS + TP + b * 192 + j8 * 8) = make_uint4(pack2(v[0], v[1]), pack2(v[2], v[3]), pack2(v[4], v[5]), pack2(v[6], v[7]));
  }
  for (size_t e = g0; e < (size_t)8 * 64 * 512; e += gsz) {
    const int c = (int)(e % 512), j8 = (int)((e / 512) % 64), b = (int)(e / (512 * 64));
    const float* s = p.in[5] + ((size_t)(l * 8 + b) * 512 + j8 * 8) * 512 + c;
    float v[8];
#pragma unroll
    for (int q = 0; q < 8; ++q) v[q] = s[(size_t)q * 512];
    *(uint4*)(Vtb + (size_t)c * KB_ROWS + TP + b * 576 + j8 * 8) = make_uint4(pack2(v[0], v[1]), pack2(v[2], v[3]), pack2(v[4], v[5]), pack2(v[6], v[7]));
  }
}

DI void p1_tile(const Params& p, int l, int rt, int ct, char* smem) {
  const int tid = tidx();
  unsigned char* ws = p.ws;
  float* Ct = (float*)smem; float* rs = (float*)(smem + 73728);
  const float* rowsq1 = (const float*)(ws + OFF_ROWSQ1);
  const int row0 = rt * 128;
  if (tid < 128) rs[tid] = rsqrtf(rowsq1[row0 + tid] * (1.f / 1024.f) + EPS);
  f32x4 acc[4][4];
  gemm_tile<4>(acc, (const u16*)(ws + OFF_XB), LDX, row0, 0, T, (const u16*)(ws + OFF_WIN) + (size_t)ct * 128 * LDW1, LDW1, 1024, smem);
  acc_to_lds<4>(acc, Ct, rs);
  int kind, cb;
  u16* dst; int dstw;
  bool isB = false; int hplane = 0;
  if (ct < 4)       { kind = 0; cb = ct * 128;        dst = (u16*)(ws + OFF_QA); dstw = 512; }
  else if (ct == 4) { kind = 1; cb = 0;               dst = (u16*)(ws + OFF_KA); dstw = 128; }
  else if (ct == 5) { kind = 2; cb = 0;               dst = (u16*)(ws + OFF_VTA); dstw = 128; }
  else if (ct < 10) { kind = 3; cb = (ct - 6) * 128;  dst = (u16*)(ws + OFF_QB); dstw = 512; isB = true; }
  else if (ct < 14) { kind = 4; cb = (ct - 10) * 128; dst = (u16*)(ws + OFF_KB); dstw = 512; isB = true; }
  else if (ct < 18) { kind = 2; cb = (ct - 14) * 128; dst = (u16*)(ws + OFF_VTB); dstw = 512; isB = true; }
  else { kind = 3; hplane = (ct - 18) >> 2; cb = ((ct - 18) & 3) * 128; dst = (u16*)(ws + OFF_HF + (size_t)hplane * PLANE); dstw = 512; }
  const bool rope = (kind == 0 || kind == 1);
  const bool iskv = (kind == 1 || kind == 2 || kind == 4);
  const int R = isB ? 512 : 128;
  float* cache_p = nullptr; float* cache_s = nullptr;
  if (iskv) {
    const bool isv = (kind == 2);
    cache_p = p.out + (isB ? (isv ? O_BVP : O_BKP) : (isv ? O_AVP : O_AKP)) + (size_t)l * R * dstw;
    cache_s = p.out + (isB ? (isv ? O_BVS : O_BKS) : (isv ? O_AVS : O_AKS)) + (size_t)l * 8 * R * dstw;
  }
#pragma unroll 1
  for (int i = 0; i < 4; ++i) {
    const int item = tid + NT * i; const int r = item >> 3, g = item & 7;
    const int tok = row0 + r;
    float v[16];
#pragma unroll
    for (int q = 0; q < 4; ++q) { const float4 t4 = *(const float4*)(Ct + r * CTS + g * 16 + q * 4); v[q * 4] = t4.x; v[q * 4 + 1] = t4.y; v[q * 4 + 2] = t4.z; v[q * 4 + 3] = t4.w; }
    if (rope && (g & 3) == 0) {
      const float pos = (float)(tok < TP ? tok : 1024 + ((tok - TP) & 63));
#pragma unroll
      for (int d = 0; d < 8; ++d) {
        const float invf = exp2f(-(float)d * (18.931568569324174f / 8.f));
        float sn, cs; sincosf(pos * invf, &sn, &cs);
        const float x1 = v[d], x2 = v[d + 8];
        v[d] = x1 * cs - x2 * sn; v[d + 8] = x2 * cs + x1 * sn;
      }
    }
    const int col = cb + g * 16;
    if (kind != 2) {
      size_t drow;
      if (kind == 1) drow = (size_t)krowA(tok); else if (kind == 4) drow = (size_t)krowB(tok); else drow = (size_t)tok;
      u16* d = dst + drow * dstw + col;
      *(uint4*)d = make_uint4(pack2(v[0], v[1]), pack2(v[2], v[3]), pack2(v[4], v[5]), pack2(v[6], v[7]));
      *(uint4*)(d + 8) = make_uint4(pack2(v[8], v[9]), pack2(v[10], v[11]), pack2(v[12], v[13]), pack2(v[14], v[15]));
    }
    if (iskv) {
      float* cd = nullptr;
      if (tok < TP) { if (tok >= TP - R) cd = cache_p + (size_t)(tok - (TP - R)) * dstw + col; }
      else { const int s = tok - TP; cd = cache_s + ((size_t)(s >> 6) * R + (R - 64) + (s & 63)) * dstw + col; }
      if (cd) {
#pragma unroll
        for (int q = 0; q < 4; ++q) *(float4*)(cd + q * 4) = make_float4(v[q * 4], v[q * 4 + 1], v[q * 4 + 2], v[q * 4 + 3]);
      }
    }
  }
  if (kind == 2) {
    const int ROWS = isB ? KB_ROWS : KA_ROWS;
#pragma unroll 1
    for (int i = 0; i < 8; ++i) {
      const int item = tid + NT * i; const int g8 = item & 15, c = item >> 4;
      float v[8];
#pragma unroll
      for (int q = 0; q < 8; ++q) v[q] = Ct[(g8 * 8 + q) * CTS + c];
      const int tok = row0 + g8 * 8;
      const int kr = isB ? krowB(tok) : krowA(tok);
      *(uint4*)(dst + (size_t)(cb + c) * ROWS + kr) = make_uint4(pack2(v[0], v[1]), pack2(v[2], v[3]), pack2(v[4], v[5]), pack2(v[6], v[7]));
    }
  }
  __syncthreads();
}

constexpr int AT_KS = 2048;
template <bool ISB>
DI void attn_item(const Params& p, int l, int sc, int hh, char* smem) {
  constexpr int GB = ISB ? 6 : 12;
  constexpr int NG = ISB ? 6 : 1, NQH = ISB ? 1 : 4;
  constexpr int NCH = GB / 2;
  constexpr int VROW = (GB * 16 + 8) * 2;
  constexpr int AT_VS = AT_KS + GB * 16 * 144;
  const int tid = tidx(), lane = tid & 63, wid = tid >> 6, fr = lane & 15, fq = lane >> 4;
  constexpr int KW = ISB ? 512 : 128;
  constexpr int KROWS = ISB ? KB_ROWS : KA_ROWS;
  constexpr int R = ISB ? 512 : 128;
  u16* Q = (u16*)(p.ws + (ISB ? OFF_QB : OFF_QA));
  const u16* Kp = (const u16*)(p.ws + (ISB ? OFF_KB : OFF_KA));
  const u16* Vt = (const u16*)(p.ws + (ISB ? OFF_VTB : OFF_VTA));
  int tokq0, kband0, firstblk;
  if (sc < 256) { tokq0 = sc * 64; kband0 = sc * 64 - R; firstblk = kband0 < 0 ? ((-kband0) >> 4) : 0; }
  else { const int b = sc - 256; tokq0 = TP + b * 64; kband0 = TP + b * (R + 64); firstblk = 0; }
  const int hk = hh;
  const int qrow = tokq0 + wid * 16 + fr;
  const float* table = (const float*)smem;
  float tconst = 0.f;
  __syncthreads();
  if (ISB) {
    const float* gt = p.in[11] + (size_t)(l * 8 + hh) * 257;
    float* tw = (float*)smem;
    tw[tid] = gt[tid]; if (tid < 64) tw[256 + tid] = gt[256];
  }
  const int qi = wid * 16 + fr;
  const float* eb = table + (65 + qi - fq * 4);
  float m_run = -1e30f, l_run = 0.f;
  f32x4 o[4];
#pragma unroll
  for (int d = 0; d < 4; ++d) o[d] = f32x4{0.f, 0.f, 0.f, 0.f};
  bf16x8 qf[2];
  if (NQH == 1) {
#pragma unroll
    for (int kk = 0; kk < 2; ++kk) qf[kk] = *(const bf16x8*)(Q + (size_t)qrow * 512 + hh * 64 + kk * 32 + fq * 8);
  }
  uint4 kreg[NCH], vreg[NCH];
#define AT_LOAD(g_) do { const int fbl = max(firstblk - (g_) * GB, 0); const int kbl = kband0 + (g_) * (GB * 16); \
    _Pragma("unroll") for (int i = 0; i < NCH; ++i) { const int c = tid + NT * i; \
      { const int row = c >> 3, ch = c & 7; kreg[i] = make_uint4(0u, 0u, 0u, 0u); \
        if (row >= fbl * 16) kreg[i] = *(const uint4*)(Kp + (size_t)(kbl + row) * KW + hk * 64 + ch * 8); } \
      { const int row = c / (GB * 2), ch = c - row * (GB * 2); vreg[i] = make_uint4(0u, 0u, 0u, 0u); \
        if (ch * 8 >= fbl * 16) vreg[i] = *(const uint4*)(Vt + (size_t)(hk * 64 + row) * KROWS + kbl + ch * 8); } } } while (0)
#define AT_STORE() do { _Pragma("unroll") for (int i = 0; i < NCH; ++i) { const int c = tid + NT * i; \
      { const int row = c >> 3, ch = c & 7; *(uint4*)(smem + AT_KS + row * 144 + ch * 16) = kreg[i]; } \
      { const int row = c / (GB * 2), ch = c - row * (GB * 2); *(uint4*)(smem + AT_VS + row * VROW + ch * 16) = vreg[i]; } } } while (0)
  const int g0 = firstblk / GB;
  AT_LOAD(g0);
  AT_STORE();
  __syncthreads();
  if (ISB) tconst = table[256];
#pragma unroll 1
  for (int g = g0; g < NG; ++g) {
    const int fb = max(firstblk - g * GB, 0);
    if (g + 1 < NG) AT_LOAD(g + 1);
    __builtin_amdgcn_sched_barrier(0);
#pragma unroll 1
    for (int qh = 0; qh < NQH; ++qh) {
      const int h = ISB ? hh : hh * 4 + qh;
      if (NQH > 1) {
#pragma unroll
        for (int kk = 0; kk < 2; ++kk) qf[kk] = *(const bf16x8*)(Q + (size_t)qrow * 512 + h * 64 + kk * 32 + fq * 8);
        m_run = p.in[10][l * 8 + h]; l_run = 1.f;
#pragma unroll
        for (int d = 0; d < 4; ++d) o[d] = f32x4{0.f, 0.f, 0.f, 0.f};
      }
      f32x4 s[GB];
#pragma unroll
      for (int blk = 0; blk < GB; ++blk) {
        f32x4 a = {0.f, 0.f, 0.f, 0.f};
        if ((blk & 3) == 0) asm volatile("" ::: "memory");
        if (blk >= fb) {
          const char* kr = smem + AT_KS + (blk * 16 + fr) * 144 + fq * 16;
          const bf16x8 k0 = *(const bf16x8*)kr, k1 = *(const bf16x8*)(kr + 64);
          a = MFMA16(k0, qf[0], a); a = MFMA16(k1, qf[1], a);
        }
        s[blk] = a;
      }
      float mx = -1e30f;
#pragma unroll
      for (int blk = 0; blk < GB; ++blk) {
#pragma unroll
        for (int j = 0; j < 4; ++j) {
          float v = s[blk][j] * 0.125f;
          if (ISB) {
            if (g < 4) v += tconst;
            else v += eb[191 - ((g - 4) * 96 + blk * 16 + j)];
          }
          if (blk < fb) v = -1e30f;
          s[blk][j] = v; mx = fmaxf(mx, v);
        }
      }
      mx = fmaxf(mx, __shfl_xor(mx, 16, 64)); mx = fmaxf(mx, __shfl_xor(mx, 32, 64));
      const float m_new = fmaxf(m_run, mx);
      const float scale = __expf(m_run - m_new);
      m_run = m_new;
      float sum = 0.f;
#pragma unroll
      for (int blk = 0; blk < GB; ++blk)
#pragma unroll
        for (int j = 0; j < 4; ++j) { const float e = __expf(s[blk][j] - m_new); s[blk][j] = e; sum += e; }
      sum += __shfl_xor(sum, 16, 64); sum += __shfl_xor(sum, 32, 64);
      l_run = l_run * scale + sum;
#pragma unroll
      for (int d = 0; d < 4; ++d) { o[d][0] *= scale; o[d][1] *= scale; o[d][2] *= scale; o[d][3] *= scale; }
#pragma unroll
      for (int pp = 0; pp < GB / 2; ++pp) {
        if ((pp & 1) == 0) asm volatile("" ::: "memory");
        if (2 * pp >= fb) {
          uint4 pk = make_uint4(pack2(s[2 * pp][0], s[2 * pp][1]), pack2(s[2 * pp][2], s[2 * pp][3]),
                                pack2(s[2 * pp + 1][0], s[2 * pp + 1][1]), pack2(s[2 * pp + 1][2], s[2 * pp + 1][3]));
          const bf16x8 pb = __builtin_bit_cast(bf16x8, pk);
#pragma unroll
          for (int d = 0; d < 4; ++d) {
            const char* vr = smem + AT_VS + (d * 16 + fr) * VROW + (pp * 32 + fq * 4) * 2;
            const uint2 lo = *(const uint2*)vr, hi = *(const uint2*)(vr + 32);
            const bf16x8 va = __builtin_bit_cast(bf16x8, make_uint4(lo.x, lo.y, hi.x, hi.y));
            o[d] = MFMA16(va, pb, o[d]);
          }
        }
      }
      if (NQH > 1) {
        const float inv = rcpf_(l_run);
#pragma unroll
        for (int d = 0; d < 4; ++d)
          *(uint2*)(Q + (size_t)qrow * 512 + h * 64 + d * 16 + fq * 4) = make_uint2(pack2(o[d][0] * inv, o[d][1] * inv), pack2(o[d][2] * inv, o[d][3] * inv));
      }
    }
    if (g + 1 < NG) {
      __syncthreads();
      AT_STORE();
      __syncthreads();
    }
  }
#undef AT_LOAD
#undef AT_STORE
  if (NQH == 1) {
    const float inv = rcpf_(l_run);
#pragma unroll
    for (int d = 0; d < 4; ++d)
      *(uint2*)(Q + (size_t)qrow * 512 + hh * 64 + d * 16 + fq * 4) = make_uint2(pack2(o[d][0] * inv, o[d][1] * inv), pack2(o[d][2] * inv, o[d][3] * inv));
  }
}

using s16x4 = __attribute__((ext_vector_type(4))) short;
#define MFMA16K(a, b, c) __builtin_amdgcn_mfma_f32_16x16x16bf16_1k((a), (b), (c), 0, 0, 0)
DI s16x4 pack4(float a, float b, float c, float d) { return __builtin_bit_cast(s16x4, make_uint2(pack2(a, b), pack2(c, d))); }
constexpr int QDS = 132, KTS = 24;
template <bool OUT>
DI void hgrn_item(const Params& p, int l, int cidx, int h, char* smem) {
  const int tid = tidx(), lane = tid & 63, wid = tid >> 6, fr = lane & 15, fq = lane >> 4;
  const int kcol = tid & 127, half = tid >> 7;
  unsigned char* ws = p.ws;
  u16* QD = (u16*)smem;
  u16* KP = QD + 16 * QDS;
  u16* KDT = KP + 16 * QDS;
  u16* VT = KDT + 128 * KTS;
  float* dec = (float*)(VT + 128 * KTS);
  float* tot = dec + 128;
  float* ssum = tot + 256;
  const u16* Hf = (const u16*)(ws + OFF_HF); const u16* Hi = (const u16*)(ws + OFF_HI);
  u16* Hq = (u16*)(ws + OFF_HQ); const u16* Hog = (const u16*)(ws + OFF_HOG);
  const bool sample = OUT && cidx >= 128;
  const int tok_base = sample ? TP + (cidx - 128) * 64 : cidx * 128;
  const int nsb = sample ? 4 : 8;
  float lb = 0.f;
  if (l == 1) lb = sigmoidf_(p.in[12][512 + h * 128 + kcol] - p.in[12][h * 128 + kcol]);
  f32x4 S[8][2];
  if (OUT) {
    const float* s0 = sample ? p.in[6] + ((size_t)(l * 8 + (cidx - 128)) * 4 + h) * 16384
                             : (const float*)(ws + OFF_ST) + ((size_t)cidx * 4 + h) * 16384;
    const float* ps = s0 + (size_t)(fq * 4) * 128 + wid * 32 + fr;
#pragma unroll
    for (int kb = 0; kb < 8; ++kb) {
      asm volatile("" : "+v"(ps));
#pragma unroll
      for (int vb = 0; vb < 2; ++vb)
#pragma unroll
        for (int i = 0; i < 4; ++i) S[kb][vb][i] = ps[i * 128 + vb * 16];
      ps += 16 * 128;
    }
  } else {
#pragma unroll
    for (int kb = 0; kb < 8; ++kb)
#pragma unroll
      for (int vb = 0; vb < 2; ++vb) S[kb][vb] = f32x4{0.f, 0.f, 0.f, 0.f};
  }
  float lastsum = 0.f;
  u16 nf[8], nq[8], ni[8];
  {
    const size_t off0 = (size_t)(tok_base + half * 8) * 512 + h * 128 + kcol;
#pragma unroll
    for (int i = 0; i < 8; ++i) { nf[i] = Hf[off0 + (size_t)i * 512]; ni[i] = Hi[off0 + (size_t)i * 512]; nq[i] = OUT ? Hq[off0 + (size_t)i * 512] : (u16)0; }
  }
#pragma unroll 1
  for (int sb = 0; sb < nsb; ++sb) {
    const int tok0 = tok_base + sb * 16;
    __syncthreads();
    float lf[8], kk8[8], q8[8], vv[8];
    float zf[8], qf_[8];
#pragma unroll
    for (int i = 0; i < 8; ++i) { zf[i] = bf2f(nf[i]); qf_[i] = bf2f(nq[i]); vv[i] = bf2f(ni[i]); }
    if (sb + 1 < nsb) {
      const size_t off0 = (size_t)(tok0 + 16 + half * 8) * 512 + h * 128 + kcol;
#pragma unroll
      for (int i = 0; i < 8; ++i) { nf[i] = Hf[off0 + (size_t)i * 512]; ni[i] = Hi[off0 + (size_t)i * 512]; if (OUT) nq[i] = Hq[off0 + (size_t)i * 512]; }
    }
    __builtin_amdgcn_sched_barrier(0);
    {
      float run = 0.f;
#pragma unroll
      for (int i = 0; i < 8; ++i) {
        const float z = zf[i];
        const float e = __expf(-fabsf(z));
        const float sp = rcpf_(1.f + e);
        const float sig = z >= 0.f ? sp : e * sp;
        const float nsig = z >= 0.f ? e * sp : sp;
        float lfi;
        if (lb > 0.f) lfi = __logf(lb + (1.f - lb) * sig);
        else lfi = fminf(z, 0.f) - __logf(1.f + e);
        run += lfi; lf[i] = run;
        kk8[i] = (1.f - lb) * nsig;
        if (OUT) { const float qp = qf_[i]; q8[i] = qp * sigmoidf_(qp); } else q8[i] = 0.f;
      }
      tot[half * 128 + kcol] = run;
    }
    __syncthreads();
    {
      const float t0 = tot[kcol], t1 = tot[128 + kcol];
      const float last = t0 + t1, base = half ? t0 : 0.f;
      float kd[8];
#pragma unroll
      for (int i = 0; i < 8; ++i) {
        const float cum = base + lf[i];
        kd[i] = kk8[i] * __expf(last - cum);
        if (OUT) {
          QD[(half * 8 + i) * QDS + kcol] = f2bf(q8[i] * __expf(cum));
          KP[(half * 8 + i) * QDS + kcol] = f2bf(kk8[i] * __expf(fminf(-cum, 80.f)));
        }
      }
      *(uint4*)(KDT + kcol * KTS + half * 8) = make_uint4(pack2(kd[0], kd[1]), pack2(kd[2], kd[3]), pack2(kd[4], kd[5]), pack2(kd[6], kd[7]));
      *(uint4*)(VT + kcol * KTS + half * 8) = make_uint4(pack2(vv[0], vv[1]), pack2(vv[2], vv[3]), pack2(vv[4], vv[5]), pack2(vv[6], vv[7]));
      if (half == 0) dec[kcol] = __expf(last);
      lastsum += last;
    }
    __syncthreads();
    s16x4 vtf[2];
#pragma unroll
    for (int vb = 0; vb < 2; ++vb) vtf[vb] = *(const s16x4*)(VT + (wid * 32 + vb * 16 + fr) * KTS + fq * 4);
    if (OUT) {
      uint2 ogp[2]; float4 cn4[2];
#pragma unroll
      for (int vb = 0; vb < 2; ++vb) {
        const int vcol = h * 128 + wid * 32 + vb * 16 + fq * 4;
        ogp[vb] = *(const uint2*)(Hog + (size_t)(tok0 + fr) * 512 + vcol);
        cn4[vb] = *(const float4*)(p.in[13] + l * 512 + vcol);
      }
      __builtin_amdgcn_sched_barrier(0);
      s16x4 qdf[8];
#pragma unroll
      for (int kb = 0; kb < 8; ++kb) qdf[kb] = *(const s16x4*)(QD + fr * QDS + kb * 16 + fq * 4);
      f32x4 at = {0.f, 0.f, 0.f, 0.f};
#pragma unroll
      for (int kb = 0; kb < 8; ++kb) { const s16x4 kpf = *(const s16x4*)(KP + fr * QDS + kb * 16 + fq * 4); at = MFMA16K(kpf, qdf[kb], at); }
#pragma unroll
      for (int i = 0; i < 4; ++i) if (fq * 4 + i > fr) at[i] = 0.f;
      const s16x4 atb = pack4(at[0], at[1], at[2], at[3]);
      f32x4 ot[2];
#pragma unroll
      for (int vb = 0; vb < 2; ++vb) {
        f32x4 o = {0.f, 0.f, 0.f, 0.f};
#pragma unroll
        for (int kb = 0; kb < 8; ++kb) o = MFMA16K(pack4(S[kb][vb][0], S[kb][vb][1], S[kb][vb][2], S[kb][vb][3]), qdf[kb], o);
        o = MFMA16K(vtf[vb], atb, o);
        ot[vb] = o;
      }
      float ss = 0.f;
#pragma unroll
      for (int vb = 0; vb < 2; ++vb)
#pragma unroll
        for (int i = 0; i < 4; ++i) ss += ot[vb][i] * ot[vb][i];
      ss += __shfl_xor(ss, 16, 64); ss += __shfl_xor(ss, 32, 64);
      if (fq == 0) ssum[wid * 16 + fr] = ss;
      __syncthreads();
      const float rn = rsqrtf((ssum[fr] + ssum[16 + fr] + ssum[32 + fr] + ssum[48 + fr]) * (1.f / 128.f) + EPS);
#pragma unroll
      for (int vb = 0; vb < 2; ++vb) {
        const int vcol = h * 128 + wid * 32 + vb * 16 + fq * 4;
        const size_t off = (size_t)(tok0 + fr) * 512 + vcol;
        const float4 cn = cn4[vb];
        const float g0 = lo_f(ogp[vb].x), g1 = hi_f(ogp[vb].x), g2 = lo_f(ogp[vb].y), g3 = hi_f(ogp[vb].y);
        *(uint2*)(Hq + off) = make_uint2(pack2(ot[vb][0] * rn * cn.x * (g0 * sigmoidf_(g0)), ot[vb][1] * rn * cn.y * (g1 * sigmoidf_(g1))),
                                         pack2(ot[vb][2] * rn * cn.z * (g2 * sigmoidf_(g2)), ot[vb][3] * rn * cn.w * (g3 * sigmoidf_(g3))));
      }
    }
#pragma unroll
    for (int kb = 0; kb < 8; ++kb) {
      const float4 d4 = *(const float4*)(dec + kb * 16 + fq * 4);
      const s16x4 kdf = *(const s16x4*)(KDT + (kb * 16 + fr) * KTS + fq * 4);
#pragma unroll
      for (int vb = 0; vb < 2; ++vb) {
        f32x4 t = S[kb][vb];
        t[0] *= d4.x; t[1] *= d4.y; t[2] *= d4.z; t[3] *= d4.w;
        S[kb][vb] = MFMA16K(kdf, vtf[vb], t);
      }
    }
  }
  if (!OUT || sample) {
    float* D = OUT ? p.out + O_CS + ((size_t)(l * 8 + (cidx - 128)) * 4 + h) * 16384
                   : (float*)(ws + OFF_ST) + ((size_t)cidx * 4 + h) * 16384;
    float* pd = D + (size_t)(fq * 4) * 128 + wid * 32 + fr;
#pragma unroll
    for (int kb = 0; kb < 8; ++kb) {
      asm volatile("" : "+v"(pd));
#pragma unroll
      for (int vb = 0; vb < 2; ++vb)
#pragma unroll
        for (int i = 0; i < 4; ++i) pd[i * 128 + vb * 16] = S[kb][vb][i];
      pd += 16 * 128;
    }
    if (!OUT && half == 0) ((float*)(ws + OFF_DECAY))[((size_t)cidx * 4 + h) * 128 + kcol] = __expf(lastsum);
  }
  __syncthreads();
}

DI void hgrn_scan(const Params& p, int l) {
  float* ST = (float*)(p.ws + OFF_ST); const float* DEC = (const float*)(p.ws + OFF_DECAY);
  for (int e = blockIdx.x * NT + tidx(); e < 65536; e += gridDim.x * NT) {
    const int h = e >> 14, k = (e >> 7) & 127;
    float S = 0.f;
    float* ptr = ST + (size_t)h * 16384 + (e & 16383);
    const float* dp = DEC + h * 128 + k;
#pragma unroll 1
    for (int c0 = 0; c0 < 128; c0 += 8) {
      float d[8], dc[8];
#pragma unroll
      for (int i = 0; i < 8; ++i) { d[i] = ptr[(size_t)(c0 + i) * 65536]; dc[i] = dp[(c0 + i) * 512]; }
#pragma unroll
      for (int i = 0; i < 8; ++i) { ptr[(size_t)(c0 + i) * 65536] = S; S = dc[i] * S + d[i]; }
    }
    p.out[O_CP + (size_t)l * 65536 + e] = S;
  }
}

template <int NB>
DI void p5_tile(const Params& p, int l, int rt, int c0, char* smem) {
  const int tid = tidx(), lane = tid & 63, wid = tid >> 6, wr = wid >> 1, fq = lane >> 4;
  unsigned char* ws = p.ws;
  float* Ct = (float*)smem; float* rs = (float*)(smem + 73728);
  const float* rowsq1 = (const float*)(ws + OFF_ROWSQ1);
  const int row0 = rt * 128;
  __syncthreads();
  if (tid < 128) rs[tid] = rsqrtf(rowsq1[row0 + tid] * (1.f / 1024.f) + EPS);
  uint2 mixp[4][NB];
#pragma unroll
  for (int m = 0; m < 4; ++m)
#pragma unroll
    for (int n = 0; n < NB; ++n) mixp[m][n] = make_uint2(0u, 0u);
#pragma unroll 1
  for (int br = 0; br < 3; ++br) {
    f32x4 acc[4][NB];
    gemm_tile<NB>(acc, (const u16*)(ws + OFF_XB), LDX, row0, 0, T, (const u16*)(ws + OFF_WIN) + (size_t)(NIN1 + br * 1024 + c0) * LDW1, LDW1, 1024, smem);
    unsigned sg[4][NB];
#pragma unroll
    for (int m = 0; m < 4; ++m) {
      const float4 r4 = *(const float4*)(rs + wr * 64 + m * 16 + fq * 4);
#pragma unroll
      for (int n = 0; n < NB; ++n) {
        const unsigned q0 = (unsigned)(sigmoidf_(acc[m][n][0] * r4.x) * 255.f + 0.5f), q1 = (unsigned)(sigmoidf_(acc[m][n][1] * r4.y) * 255.f + 0.5f);
        const unsigned q2 = (unsigned)(sigmoidf_(acc[m][n][2] * r4.z) * 255.f + 0.5f), q3 = (unsigned)(sigmoidf_(acc[m][n][3] * r4.w) * 255.f + 0.5f);
        unsigned w_ = q0 | (q1 << 8) | (q2 << 16) | (q3 << 24);
        asm volatile("" : "+v"(w_));
        sg[m][n] = w_;
      }
    }
    const u16* Ob = (const u16*)(ws + (br == 0 ? OFF_QA : (br == 1 ? OFF_QB : OFF_HQ)));
    gemm_tile<NB>(acc, Ob, 512, row0, 0, T, (const u16*)(ws + OFF_WA + br * W_BR_B) + (size_t)c0 * LDW5, LDW5, 512, smem);
#pragma unroll
    for (int m = 0; m < 4; ++m)
#pragma unroll
      for (int n = 0; n < NB; ++n) {
        const uint2 prev = mixp[m][n];
        const unsigned w = sg[m][n];
        const float k255 = 1.f / 255.f;
        const float m0 = lo_f(prev.x) + (float)(w & 255u) * k255 * acc[m][n][0], m1 = hi_f(prev.x) + (float)((w >> 8) & 255u) * k255 * acc[m][n][1];
        const float m2 = lo_f(prev.y) + (float)((w >> 16) & 255u) * k255 * acc[m][n][2], m3 = hi_f(prev.y) + (float)(w >> 24) * k255 * acc[m][n][3];
        unsigned px = pack2(m0, m1), py = pack2(m2, m3);
        asm volatile("" : "+v"(px), "+v"(py));
        mixp[m][n] = make_uint2(px, py);
      }
  }
  {
    f32x4 mix[4][NB];
#pragma unroll
    for (int m = 0; m < 4; ++m)
#pragma unroll
      for (int n = 0; n < NB; ++n) { const uint2 q = mixp[m][n]; mix[m][n] = f32x4{lo_f(q.x), hi_f(q.x), lo_f(q.y), hi_f(q.y)}; }
    acc_to_lds<NB>(mix, Ct, nullptr);
  }
  u16* mixb = (u16*)(ws + OFF_MIX);
#pragma unroll 1
  for (int i = 0; i < NB; ++i) {
    const int item = tid + NT * i; const int r = item / (NB * 2), g = item % (NB * 2);
    float v[16];
#pragma unroll
    for (int q = 0; q < 4; ++q) { const float4 t4 = *(const float4*)(Ct + r * CTS + g * 16 + q * 4); v[q * 4] = t4.x; v[q * 4 + 1] = t4.y; v[q * 4 + 2] = t4.z; v[q * 4 + 3] = t4.w; }
    u16* d = mixb + (size_t)(row0 + r) * LDX + c0 + g * 16;
    *(uint4*)d = make_uint4(pack2(v[0], v[1]), pack2(v[2], v[3]), pack2(v[4], v[5]), pack2(v[6], v[7]));
    *(uint4*)(d + 8) = make_uint4(pack2(v[8], v[9]), pack2(v[10], v[11]), pack2(v[12], v[13]), pack2(v[14], v[15]));
  }
  __syncthreads();
}

template <int NB>
DI void resid_tile(const Params& p, const u16* A, int lda, const u16* W, int ldw, int K, float* rowsq, int rt, int c0, char* smem) {
  const int tid = tidx();
  float* Ct = (float*)smem;
  const int row0 = rt * 128;
  constexpr int NGRP = NB * 2;
  f32x4 acc[4][NB];
  gemm_tile<NB>(acc, A, lda, row0, 0, T, W + (size_t)c0 * ldw, ldw, K, smem);
  acc_to_lds<NB>(acc, Ct, nullptr);
  float* x = p.out; u16* xb = (u16*)(p.ws + OFF_XB);
#pragma unroll
  for (int i = 0; i < NB; ++i) {
    const int item = tid + NT * i; const int r = item / NGRP, g = item % NGRP;
    float* xp = x + (size_t)(row0 + r) * 1024 + c0 + g * 16;
    float v[16]; float ss = 0.f;
#pragma unroll
    for (int q = 0; q < 4; ++q) {
      const float4 t4 = *(const float4*)(Ct + r * CTS + g * 16 + q * 4); float4 x4 = *(const float4*)(xp + q * 4);
      x4.x += t4.x; x4.y += t4.y; x4.z += t4.z; x4.w += t4.w;
      *(float4*)(xp + q * 4) = x4;
      v[q * 4] = x4.x; v[q * 4 + 1] = x4.y; v[q * 4 + 2] = x4.z; v[q * 4 + 3] = x4.w;
      ss += x4.x * x4.x + x4.y * x4.y + x4.z * x4.z + x4.w * x4.w;
    }
    u16* d = xb + (size_t)(row0 + r) * LDX + c0 + g * 16;
    *(uint4*)d = make_uint4(pack2(v[0], v[1]), pack2(v[2], v[3]), pack2(v[4], v[5]), pack2(v[6], v[7]));
    *(uint4*)(d + 8) = make_uint4(pack2(v[8], v[9]), pack2(v[10], v[11]), pack2(v[12], v[13]), pack2(v[14], v[15]));
    ss += __shfl_xor(ss, 1, 64);
    if (NGRP > 2) { ss += __shfl_xor(ss, 2, 64); ss += __shfl_xor(ss, 4, 64); }
    if (g == 0) atomicAdd(rowsq + row0 + r, ss);
  }
  __syncthreads();
}

DI float gelu_tanh(float g) { const float u = 0.7978845608028654f * (g + 0.044715f * g * g * g); return g * rcpf_(1.f + __expf(-2.f * u)); }
DI void p7_tile(const Params& p, int l, int rt, int ct, char* smem) {
  const int tid = tidx();
  unsigned char* ws = p.ws;
  float* Ct = (float*)smem; float* rs = (float*)(smem + 73728);
  const float* rowsq2 = (const float*)(ws + OFF_ROWSQ2);
  const bool sample = rt >= 131;
  const int base = sample ? TP + (rt - 131) * 128 : rt * 126 - 2;
  const int lo = sample ? TP : 0, hi = sample ? T : TP;
  __syncthreads();
  if (tid < 128) { const int g = base + tid; rs[tid] = (g >= lo && g < hi) ? rsqrtf(rowsq2[g] * (1.f / 1024.f) + EPS) : 0.f; }
  const float* wconv = p.in[20] + (size_t)l * 3 * DFF2; const float* bconv = p.in[21] + (size_t)l * DFF2;
  const float* cstate = p.in[7] + (size_t)l * 8 * 2 * DFF2;
  u16* act = (u16*)(ws + OFF_ACT);
  const int jp = tid & 31;
  float cw[4][4];
#pragma unroll
  for (int q = 0; q < 2; ++q)
#pragma unroll
    for (int ug = 0; ug < 2; ++ug) {
      const int oc = ug * DFF + ct * 64 + jp * 2 + q;
      cw[q * 2 + ug][0] = bconv[oc]; cw[q * 2 + ug][1] = wconv[oc]; cw[q * 2 + ug][2] = wconv[DFF2 + oc]; cw[q * 2 + ug][3] = wconv[2 * DFF2 + oc];
    }
  f32x4 acc[4][4];
  gemm_tile<4>(acc, (const u16*)(ws + OFF_XB), LDX, base, lo, hi, (const u16*)(ws + OFF_WUP) + (size_t)ct * 128 * LDW1, LDW1, 1024, smem);
  acc_to_lds<4>(acc, Ct, rs);
  const int rbase = (tid >> 5) * 16;
  float w1[4], w0[4];
#pragma unroll
  for (int c = 0; c < 4; ++c) {
    const int lc = jp * 2 + (c >> 1) + (c & 1) * 64;
    w1[c] = rbase >= 1 ? Ct[(rbase - 1) * CTS + lc] : 0.f;
    w0[c] = rbase >= 2 ? Ct[(rbase - 2) * CTS + lc] : 0.f;
  }
#pragma unroll 4
  for (int i = 0; i < 16; ++i) {
    const int r = rbase + i;
    const int tok = base + r;
    bool valid; int bi = 0, ti = 2;
    if (sample) { valid = true; bi = (tok - TP) >> 6; ti = (tok - TP) & 63; }
    else valid = (r >= 2) && (tok < TP);
    float cv[4], u2v[4];
#pragma unroll
    for (int c = 0; c < 4; ++c) {
      const int q = c >> 1, ug = c & 1;
      const int jc = jp * 2 + q;
      const int lc = jc + ug * 64;
      const int oc = ug * DFF + ct * 64 + jc;
      const float u2 = Ct[r * CTS + lc];
      float u1 = w1[c], u0 = w0[c];
      if (sample && ti < 2) { u1 = (ti >= 1) ? u1 : cstate[((size_t)bi * 2 + 1) * DFF2 + oc]; u0 = cstate[((size_t)bi * 2 + ti) * DFF2 + oc]; }
      cv[c] = cw[c][0] + cw[c][1] * u0 + cw[c][2] * u1 + cw[c][3] * u2;
      u2v[c] = u2; w0[c] = w1[c]; w1[c] = u2;
      if (valid) {
        if (!sample) { if (tok >= TP - 2) p.out[O_CVP + ((size_t)l * 2 + (tok - (TP - 2))) * DFF2 + oc] = u2; }
        else if (ti >= 62) p.out[O_CVS + (((size_t)l * 8 + bi) * 2 + (ti - 62)) * DFF2 + oc] = u2;
      }
    }
    if (valid) *(unsigned*)(act + (size_t)tok * LDACT + ct * 64 + jp * 2) = pack2(cv[0] * gelu_tanh(cv[1]), cv[2] * gelu_tanh(cv[3]));
  }
  __syncthreads();
}

DI void final_norm(const Params& p) {
  const int lane = tidx() & 63, wid = tidx() >> 6;
  const float* rowsq1 = (const float*)(p.ws + OFF_ROWSQ1);
  for (int it = blockIdx.x; it < T / 4; it += gridDim.x) {
    const int row = it * 4 + wid;
    const float rstd = rsqrtf(rowsq1[row] * (1.f / 1024.f) + EPS);
#pragma unroll
    for (int i = 0; i < 4; ++i) {
      const int c = (i * 64 + lane) * 4;
      float4 v = *(float4*)(p.out + (size_t)row * 1024 + c);
      const float4 g = *(const float4*)(p.in[23] + c);
      v.x *= rstd * g.x; v.y *= rstd * g.y; v.z *= rstd * g.z; v.w *= rstd * g.w;
      *(float4*)(p.out + (size_t)row * 1024 + c) = v;
    }
  }
}

DI int vblock(int b, int G) { const int nper = G >> 3; return (G & 7) ? b : ((b & 7) * nper + (b >> 3)); }
DI void tile_map(int j, int nrt, int nct, int& rt, int& ct) {
  constexpr int GR = TILE_GR;
  const int gw = GR * nct; const int g = j / gw, w = j - g * gw; const int gsz = min(GR, nrt - GR * g);
  ct = w / gsz; rt = GR * g + (w - ct * gsz);
}

__global__ void __launch_bounds__(NT, 2) fwd_megakernel(Params p) {
  extern __shared__ __attribute__((aligned(16))) char smem[];
  cg::grid_group grid = cg::this_grid();
#if USE_CG_SYNC
#define GSYNC() grid.sync()
#else
  __shared__ uint4 xb_words;
  if (threadIdx.x == 0) xb_words = make_uint4(0u, 0u, 0u, 0u);
  __syncthreads();
  XcdBarrier xb = xcd_barrier_post((unsigned*)(p.ws + OFF_BAR), (volatile LAS unsigned*)&xb_words);
  if (gridDim.y == 12345u) grid.sync();
#define GSYNC() xcd_barrier(xb)
#endif
  const int G = gridDim.x, bid = blockIdx.x;
  int vb = vblock(bid, G);
  int rt_, ct_;
  unsigned long long tacc = 0, tmark = 0;
#define TBEG(id) do { if (TPROBE == (id)) tmark = __builtin_amdgcn_s_memrealtime(); } while (0)
#define TEND(id) do { if (TPROBE == (id)) tacc += __builtin_amdgcn_s_memrealtime() - tmark; } while (0)
  unsigned char* ws = p.ws;
  TBEG(9); if (PHM & 1) phase0(p, smem);
  GSYNC(); TEND(9);
#if !USE_CG_SYNC
  {
    unsigned* bar = (unsigned*)(p.ws + OFF_BAR);
    bool even = (G & 7) == 0;
    for (int j = 0; j < 16; ++j) { const unsigned c = xb_ld(&bar[XB_XCNT(j)]); even = even && (c == (j < 8 ? (unsigned)(G >> 3) : 0u)); }
    if (even) vb = (int)xb.x * (G >> 3) + (int)xb_words.z;
  }
#endif
  for (int l = 0; l < 2; ++l) {
    TBEG(1);
    if (PHM & 2) cache_to_kv(p, l);
    for (int rep = 0; rep < ((DBL & 1) ? 2 : 1); ++rep)
    if (PHM & 2) for (int it = vb; it < 132 * 34; it += G) { tile_map(it, 132, 34, rt_, ct_); p1_tile(p, l, rt_, ct_, smem); }
    { float* rq2 = (float*)(ws + OFF_ROWSQ2); for (int i = bid * NT + threadIdx.x; i < T; i += G * NT) rq2[i] = 0.f; }
    GSYNC(); TEND(1);
    TBEG(2);
    for (int it = bid; it < 264 * 8 + 512 + 264 * 2 + 32; it += G) {
      if (it < 2112) { if (PHM & 4) attn_item<true>(p, l, it >> 3, it & 7, smem); }
      else if (it < 2624) { const int j = it - 2112; if (PHM & 8) hgrn_item<false>(p, l, j >> 2, j & 3, smem); }
      else if (it < 3152) { const int j = it - 2624; if (PHM & 16) attn_item<false>(p, l, j >> 1, j & 1, smem); }
      else { const int j = it - 3152; hgrn_item<true>(p, l, 128 + (j >> 2), j & 3, smem); }
    }
    GSYNC(); TEND(2);
    TBEG(3);
    if (PHM & 32) hgrn_scan(p, l);
    GSYNC(); TEND(3);
    TBEG(4);
    if (PHM & 64) for (int it = bid; it < 128 * 4; it += G) hgrn_item<true>(p, l, it >> 2, it & 3, smem);
    GSYNC(); TEND(4);
    TBEG(5);
    for (int rep = 0; rep < ((DBL & 2) ? 2 : 1); ++rep)
    if (PHM & 256) for (int it = vb; it < 1024 + 64; it += G) {
      if (it < 1024) { tile_map(it, 128, 8, rt_, ct_); p5_tile<4>(p, l, rt_, ct_ * 128, smem); }
      else { const int j = it - 1024; p5_tile<2>(p, l, 128 + (j >> 4), (j & 15) * 64, smem); }
    }
    if (PHM & 128) {
      if (G > 128) { if (vb >= 64) for (int it = vb - 64; it < NCONV_FFN; it += G - 64) conv_wffn_item(p, l, it, smem); }
      else for (int it = vb; it < NCONV_FFN; it += G) conv_wffn_item(p, l, it, smem);
    }
    GSYNC(); TEND(5);
    TBEG(6);
    { float* rq1 = (float*)(ws + OFF_ROWSQ1); for (int i = bid * NT + threadIdx.x; i < T; i += G * NT) rq1[i] = 0.f; }
    if (PHM & 512) for (int it = vb; it < 1024 + 128; it += G) {
      if (it < 1024) { tile_map(it, 128, 8, rt_, ct_);
        resid_tile<4>(p, (const u16*)(ws + OFF_MIX), LDX, (const u16*)(ws + OFF_WOUT), LDW1, 1024, (float*)(ws + OFF_ROWSQ2), rt_, ct_ * 128, smem); }
      else { const int j = it - 1024;
        resid_tile<1>(p, (const u16*)(ws + OFF_MIX), LDX, (const u16*)(ws + OFF_WOUT), LDW1, 1024, (float*)(ws + OFF_ROWSQ2), 128 + (j >> 5), (j & 31) * 32, smem); }
    }
    GSYNC(); TEND(6);
    TBEG(7);
    for (int rep = 0; rep < ((DBL & 4) ? 2 : 1); ++rep)
    if (PHM & 1024) for (int it = vb; it < 135 * 44; it += G) { tile_map(it, 135, 44, rt_, ct_); p7_tile(p, l, rt_, ct_, smem); }
    GSYNC(); TEND(7);
    TBEG(8);
    if (PHM & 2048) for (int it = vb; it < 1024 + 128; it += G) {
      if (it < 1024) { tile_map(it, 128, 8, rt_, ct_);
        resid_tile<4>(p, (const u16*)(ws + OFF_ACT), LDACT, (const u16*)(ws + OFF_WDOWN), LDACT, DFF, (float*)(ws + OFF_ROWSQ1), rt_, ct_ * 128, smem); }
      else { const int j = it - 1024;
        resid_tile<1>(p, (const u16*)(ws + OFF_ACT), LDACT, (const u16*)(ws + OFF_WDOWN), LDACT, DFF, (float*)(ws + OFF_ROWSQ1), 128 + (j >> 5), (j & 31) * 32, smem); }
    }
    if (l == 0) {
      if (G > 256) { if (vb >= 128) for (int it = vb - 128; it < NCONV_MIX; it += G - 128) conv_wmix_item(p, 1, it, smem); }
      else for (int it = vb; it < NCONV_MIX; it += G) conv_wmix_item(p, 1, it, smem);
    }
    GSYNC(); TEND(8);
  }
  final_norm(p);
  if (TPROBE != 0 && bid == 0) { const unsigned long long t0 = __builtin_amdgcn_s_memrealtime(); while (__builtin_amdgcn_s_memrealtime() - t0 < 4 * tacc) __builtin_amdgcn_s_sleep(8); }
}

extern "C" void kernel_launch(void* const* d_in, const int* in_sizes, int n_in, void* d_out, int out_size,
                              void* d_ws, size_t ws_size, hipStream_t stream) {
  static int grid_blocks = 0;
  if (!grid_blocks) {
    int dev = 0, cus = 0, per_cu = 0;
    hipGetDevice(&dev);
    hipDeviceGetAttribute(&cus, hipDeviceAttributeMultiprocessorCount, dev);
    hipFuncSetAttribute((const void*)fwd_megakernel, hipFuncAttributeMaxDynamicSharedMemorySize, LDS_BYTES);
    hipOccupancyMaxActiveBlocksPerMultiprocessor(&per_cu, (const void*)fwd_megakernel, NT, LDS_BYTES);
    if (per_cu < 1) per_cu = 1;
    if (per_cu > 2) per_cu = 2;
    grid_blocks = cus * per_cu;
    if (grid_blocks > 512) grid_blocks = 512;
    if (ws_size < WS_END2 || (size_t)out_size < O_END || n_in < 24)
      fprintf(stderr, "kernel_launch: unexpected sizes ws=%zu need=%zu out=%d need=%zu n_in=%d\n", ws_size, (size_t)WS_END, out_size, (size_t)O_END, n_in);
  }
  Params p{};
  for (int i = 0; i < 24; ++i) p.in[i] = (const float*)d_in[i];
  p.out = (float*)d_out; p.ws = (unsigned char*)d_ws;
  hipMemsetAsync((char*)d_ws + OFF_BAR, 0, 16384, stream);
  void* args[] = {&p};
  hipError_t e = hipLaunchCooperativeKernel((const void*)fwd_megakernel, dim3(grid_blocks), dim3(NT), args, LDS_BYTES, stream);
  if (e != hipSuccess) fprintf(stderr, "cooperative launch failed: %s (grid %d)\n", hipGetErrorString(e), grid_blocks);
}
```

```cpp
#include <hip/hip_runtime.h>
#include <hip/hip_cooperative_groups.h>
#include <cstdio>
namespace cg = cooperative_groups;

typedef unsigned short u16;
using bf16x8 = __attribute__((ext_vector_type(8))) short;
using f32x4 = __attribute__((ext_vector_type(4))) float;
#define DI __device__ __forceinline__
#define MFMA16(a, b, c) __builtin_amdgcn_mfma_f32_16x16x32_bf16((a), (b), (c), 0, 0, 0)

#ifndef PHM
#define PHM 0xFFFF
#endif
#ifndef DBL
#define DBL 0
#endif
#ifndef TPROBE
#define TPROBE 0
#endif
#ifndef TILE_GR
#define TILE_GR 8
#endif
#ifndef USE_CG_SYNC
#define USE_CG_SYNC 0
#endif

constexpr int DM = 1024, TP = 16384, TS = 512, T = TP + TS, NBATCH = 8;
constexpr int INW = 7424, NIN1 = 4352;
constexpr int DFF = 2816, DFF2 = 5632;
constexpr int KA_ROWS = TP + NBATCH * 192, KB_ROWS = TP + NBATCH * 576;
constexpr int NT = 256;
constexpr float EPS = 1e-6f;
constexpr int LDX = 1088, LDW1 = 1088, LDW5 = 576, LDACT = 2880;
constexpr int LDS_BYTES = 73728 + 1024;

constexpr size_t OFF_BAR   = 0;
constexpr size_t OFF_ROWSQ1 = 16384;
constexpr size_t OFF_ROWSQ2 = OFF_ROWSQ1 + 67584;
constexpr size_t OFF_DECAY = OFF_ROWSQ2 + 67584;
constexpr size_t OFF_WMIX  = OFF_DECAY + 262144;
constexpr size_t W_IN_B = (size_t)INW * LDW1 * 2, W_BR_B = (size_t)1024 * LDW5 * 2, W_OUT_B = (size_t)1024 * LDW1 * 2;
constexpr size_t OFF_WIN = OFF_WMIX, OFF_WA = OFF_WIN + W_IN_B, OFF_WB = OFF_WA + W_BR_B, OFF_WC = OFF_WB + W_BR_B, OFF_WOUT = OFF_WC + W_BR_B;
constexpr size_t OFF_XB    = OFF_WOUT + W_OUT_B;
constexpr size_t OFF_ST    = OFF_XB + (size_t)T * LDX * 2;
constexpr size_t OFF_WUP = OFF_ST, OFF_WDOWN = OFF_ST + (size_t)DFF2 * LDW1 * 2;
static_assert(OFF_WDOWN + (size_t)1024 * LDACT * 2 <= OFF_ST + (size_t)128 * 4 * 16384 * 4, "ffn weights fit the state region");
constexpr size_t OFF_QA    = OFF_ST + (size_t)128 * 4 * 16384 * 4;
constexpr size_t PLANE = (size_t)T * 512 * 2;
constexpr size_t OFF_QB    = OFF_QA + PLANE;
constexpr size_t OFF_KA    = OFF_QB + PLANE;
constexpr size_t OFF_VTA   = OFF_KA + (size_t)KA_ROWS * 128 * 2;
constexpr size_t OFF_KB    = OFF_VTA + (size_t)KA_ROWS * 128 * 2;
constexpr size_t OFF_VTB   = OFF_KB + (size_t)KB_ROWS * 512 * 2;
constexpr size_t OFF_HF    = OFF_VTB + (size_t)KB_ROWS * 512 * 2;
constexpr size_t OFF_HI = OFF_HF + PLANE, OFF_HQ = OFF_HI + PLANE, OFF_HOG = OFF_HQ + PLANE;
constexpr size_t WS_END = OFF_HOG + PLANE;
constexpr size_t OFF_P5S = WS_END;
constexpr size_t WS_END2 = OFF_P5S + (size_t)512 * 32768;
static_assert(WS_END2 <= (size_t)256 * 1024 * 1024, "workspace budget");
constexpr size_t OFF_MIX = OFF_KB;
static_assert((size_t)T * LDX * 2 <= 2 * (size_t)KB_ROWS * 512 * 2, "mix fits");
constexpr size_t OFF_ACT = OFF_QA;
static_assert(OFF_ACT + (size_t)T * LDACT * 2 <= OFF_HQ, "act fits");

constexpr size_t O_X = 0;
constexpr size_t O_AKP = (size_t)T * 1024;
constexpr size_t O_AVP = O_AKP + 32768;
constexpr size_t O_BKP = O_AVP + 32768;
constexpr size_t O_BVP = O_BKP + 524288;
constexpr size_t O_CP  = O_BVP + 524288;
constexpr size_t O_CVP = O_CP + 131072;
constexpr size_t O_AKS = O_CVP + 22528;
constexpr size_t O_AVS = O_AKS + 262144;
constexpr size_t O_BKS = O_AVS + 262144;
constexpr size_t O_BVS = O_BKS + 4194304;
constexpr size_t O_CS  = O_BVS + 4194304;
constexpr size_t O_CVS = O_CS + 1048576;
constexpr size_t O_END = O_CVS + 180224;

struct Params { const float* in[24]; float* out; unsigned char* ws; };

DI u16 f2bf(float x) { unsigned u = __float_as_uint(x); u += 0x7fffu + ((u >> 16) & 1u); return (u16)(u >> 16); }
DI float bf2f(u16 v) { return __uint_as_float(((unsigned)v) << 16); }
typedef __bf16 bf16x2_t __attribute__((ext_vector_type(2)));
DI unsigned pack2(float a, float b) { bf16x2_t v = {(__bf16)a, (__bf16)b}; return __builtin_bit_cast(unsigned, v); }
DI float lo_f(unsigned u) { return __uint_as_float(u << 16); }
DI float hi_f(unsigned u) { return __uint_as_float(u & 0xffff0000u); }
DI float wave_sum(float v) {
#pragma unroll
  for (int o = 32; o >= 1; o >>= 1) v += __shfl_xor(v, o, 64);
  return v;
}
DI int tidx() { int t = threadIdx.x; asm volatile("" : "+v"(t)); return t; }
DI float rcpf_(float x) { return __builtin_amdgcn_rcpf(x); }
DI float sigmoidf_(float x) { return rcpf_(1.f + __expf(-x)); }
DI int krowA(int tok) { if (tok < TP) return tok; int s = tok - TP; return TP + (s >> 6) * 192 + 128 + (s & 63); }
DI int krowB(int tok) { if (tok < TP) return tok; int s = tok - TP; return TP + (s >> 6) * 576 + 512 + (s & 63); }

#define XB_TMO      128
#define XB_XCNT(j)  (256  + 64 * (j))
#define XB_XSUB(j)  (1280 + 64 * (j))
#define XB_XGEN(j)  (2304 + 64 * (j))
#define XB_TOP      3328
#define XB_TOPGEN   3392
#define XCD_BAR_WORDS 3456
#define XB_SPIN_CAP (1u << 24)
#define LAS __attribute__((address_space(3)))
DI unsigned xb_ld(unsigned* p) { return __hip_atomic_load(p, __ATOMIC_RELAXED, __HIP_MEMORY_SCOPE_AGENT); }
DI unsigned xb_add(unsigned* p, unsigned v) { return __hip_atomic_fetch_add(p, v, __ATOMIC_RELAXED, __HIP_MEMORY_SCOPE_AGENT); }
DI unsigned xb_xcc_id() { return (unsigned)__builtin_amdgcn_s_getreg((3 << 11) | 20) & 0xFu; }
#define XB_SPIN(cond, bar) do { unsigned _sp = 0; while (cond) { __builtin_amdgcn_s_sleep(1); \
    if ((++_sp & 255u) == 0u) { if (xb_ld(&(bar)[XB_TMO])) break; if (_sp > XB_SPIN_CAP) { atomicAdd(&(bar)[XB_TMO], 1u); break; } } } } while (0)
struct XcdBarrier { unsigned* bar; unsigned x; volatile LAS unsigned* st; };
DI XcdBarrier xcd_barrier_post(unsigned* bar, volatile LAS unsigned* st) {
  XcdBarrier b; b.bar = bar; b.x = xb_xcc_id(); b.st = st;
  if (threadIdx.x == 0) st[2] = xb_add(&bar[XB_XCNT(b.x)], 1u);
  return b;
}
DI void xcd_barrier_complete(unsigned* bar, unsigned x, unsigned& nloc, unsigned& nx) {
  const unsigned G = gridDim.x;
  unsigned sum, cnt, mine, sp = 0u;
  for (;;) {
    sum = 0u; cnt = 0u; mine = 0u;
#pragma unroll
    for (unsigned j = 0; j < 16; ++j) { const unsigned c = xb_ld(&bar[XB_XCNT(j)]); sum += c; cnt += (c > 0u) ? 1u : 0u; mine = (j == x) ? c : mine; }
    if (sum == G) break;
    __builtin_amdgcn_s_sleep(1);
    if ((++sp & 255u) == 0u) { if (xb_ld(&bar[XB_TMO])) break; if (sp > XB_SPIN_CAP) { atomicAdd(&bar[XB_TMO], 1u); break; } }
  }
  nloc = mine > 0u ? mine : 1u; nx = cnt > 0u ? cnt : 1u;
}
DI void xcd_barrier(const XcdBarrier& b) {
  asm volatile("s_waitcnt vmcnt(0)" ::: "memory");
  __syncthreads();
  if (threadIdx.x == 0) {
    unsigned* bar = b.bar;
    __builtin_amdgcn_s_waitcnt(0);
    unsigned nloc = b.st[0], nx = b.st[1];
    if (nloc == 0u) { xcd_barrier_complete(bar, b.x, nloc, nx); b.st[0] = nloc; b.st[1] = nx; }
    const unsigned old = xb_add(&bar[XB_XSUB(b.x)], 1u);
    const unsigned gen = old / nloc;
    if (old + 1u == (gen + 1u) * nloc) {
      __builtin_amdgcn_fence(__ATOMIC_RELEASE, "agent");
      asm volatile("s_waitcnt vmcnt(0)" ::: "memory");
      const unsigned og = xb_add(&bar[XB_TOP], 1u);
      const unsigned tg = og / nx;
      if (og + 1u == (tg + 1u) * nx) xb_add(&bar[XB_TOPGEN], 1u);
      else XB_SPIN(xb_ld(&bar[XB_TOPGEN]) == tg, bar);
      __builtin_amdgcn_fence(__ATOMIC_ACQUIRE, "agent");
      xb_add(&bar[XB_XGEN(b.x)], 1u);
      asm volatile("s_waitcnt vmcnt(0)" ::: "memory");
    } else {
      XB_SPIN(xb_ld(&bar[XB_XGEN(b.x)]) == gen, bar);
      __builtin_amdgcn_fence(__ATOMIC_ACQUIRE, "agent");
      asm volatile("s_waitcnt vmcnt(0)" ::: "memory");
    }
  }
  __syncthreads();
}

template <int NB>
DI void gemm_tile(f32x4 (&acc)[4][NB], const u16* __restrict__ A, int lda, int row0, int lo, int hi,
                  const u16* __restrict__ W, int ldw, int K, char* smem) {
  const int tid = tidx(), lane = tid & 63, wid = tid >> 6, wr = wid >> 1, wc = wid & 1, fr = lane & 15, fq = lane >> 4;
  const int sr = tid >> 3, sc = tid & 7;
#pragma unroll
  for (int m = 0; m < 4; ++m)
#pragma unroll
    for (int n = 0; n < NB; ++n) acc[m][n] = f32x4{0.f, 0.f, 0.f, 0.f};
  const int g0 = row0 + sr;
  const int c0r = min(max(g0, lo), hi - 1), c1r = min(max(g0 + 32, lo), hi - 1), c2r = min(max(g0 + 64, lo), hi - 1), c3r = min(max(g0 + 96, lo), hi - 1);
  const int csw = (sc ^ ((sr >> 1) & 7)) * 8;
  const u16* ap0 = A + (size_t)c0r * lda + csw;
  const u16* ap1 = A + (size_t)c1r * lda + csw;
  const u16* ap2 = A + (size_t)c2r * lda + csw;
  const u16* ap3 = A + (size_t)c3r * lda + csw;
  const u16* wp = W + (size_t)sr * ldw + csw;
  const size_t ws32 = (size_t)32 * ldw;
  int koff = 0;
  char* sdst = smem + tid * 16;
#define GLDS(g, l) __builtin_amdgcn_global_load_lds((const __attribute__((address_space(1))) unsigned*)(g), (__attribute__((address_space(3))) unsigned*)(l), 16, 0, 0)
#define STAGE(buf) do { char* d_ = sdst + (buf) * 32768; \
    GLDS(ap0 + koff, d_); GLDS(ap1 + koff, d_ + 4096); GLDS(ap2 + koff, d_ + 8192); GLDS(ap3 + koff, d_ + 12288); \
    GLDS(wp + koff, d_ + 16384); if (NB > 1) GLDS(wp + ws32 + koff, d_ + 16384 + 4096); \
    if (NB > 2) { GLDS(wp + 2 * ws32 + koff, d_ + 16384 + 8192); GLDS(wp + 3 * ws32 + koff, d_ + 16384 + 12288); } \
    koff += 64; } while (0)
  const int fsw = (fr >> 1) & 7;
  const int fa = (wr * 64 + fr) * 128, fb = 16384 + (wc * (NB * 16) + fr) * 128;
#define COMPUTE(buf) do { const char* b = smem + (buf) * 32768; \
    _Pragma("unroll") for (int kk = 0; kk < 2; ++kk) { \
      bf16x8 af[4], bfr[NB]; \
      const int co = ((kk * 4 + fq) ^ fsw) * 16; \
      _Pragma("unroll") for (int m = 0; m < 4; ++m) af[m] = *(const bf16x8*)(b + fa + m * 2048 + co); \
      _Pragma("unroll") for (int n = 0; n < NB; ++n) bfr[n] = *(const bf16x8*)(b + fb + n * 2048 + co); \
      __builtin_amdgcn_s_setprio(1); \
      _Pragma("unroll") for (int m = 0; m < 4; ++m) \
        _Pragma("unroll") for (int n = 0; n < NB; ++n) acc[m][n] = MFMA16(af[m], bfr[n], acc[m][n]); \
      __builtin_amdgcn_s_setprio(0); \
    } } while (0)
  const int nk = K >> 6;
  STAGE(0);
  asm volatile("s_waitcnt vmcnt(0)" ::: "memory");
  __syncthreads();
#pragma unroll 4
  for (int kt = 0; kt < nk; ++kt) {
    if (kt + 1 < nk) STAGE((kt + 1) & 1);
    COMPUTE(kt & 1);
    asm volatile("s_waitcnt vmcnt(0)" ::: "memory");
    __syncthreads();
  }
#undef GLDS
#undef STAGE
#undef COMPUTE
}

constexpr int CTS = 132;
template <int NB>
DI void acc_to_lds(const f32x4 (&acc)[4][NB], float* Ct, const float* rs) {
  const int tid = tidx(), lane = tid & 63, wid = tid >> 6, wr = wid >> 1, wc = wid & 1, fr = lane & 15, fq = lane >> 4;
#pragma unroll
  for (int m = 0; m < 4; ++m)
#pragma unroll
    for (int j = 0; j < 4; ++j) {
      const int r = wr * 64 + m * 16 + fq * 4 + j;
      const float s = rs ? rs[r] : 1.f;
#pragma unroll
      for (int n = 0; n < NB; ++n) Ct[r * CTS + wc * (NB * 16) + n * 16 + fr] = acc[m][n][j] * s;
    }
  __syncthreads();
}

DI void conv_wtile(const float* __restrict__ src, int K, int N, u16* __restrict__ dst, int ldk, const float* __restrict__ gain, int permute, int tile, float* tl) {
  const int tid = tidx();
  const int nnt = N >> 6; const int kt = tile / nnt, nt = tile - kt * nnt; const int k0 = kt * 64, n0 = nt * 64;
  {
    const int n = tid & 63, kq = tid >> 6;
    float v16[16];
#pragma unroll
    for (int i = 0; i < 16; ++i) v16[i] = src[(size_t)(k0 + i * 4 + kq) * N + n0 + n];
#pragma unroll
    for (int i = 0; i < 16; ++i) { const int k = i * 4 + kq; float v = v16[i]; if (gain) v *= gain[k0 + k]; tl[k * 65 + n] = v; }
  }
  __syncthreads();
#pragma unroll
  for (int j = 0; j < 2; ++j) {
    const int n = (tid >> 3) + 32 * j, ks = tid & 7;
    float v[8];
#pragma unroll
    for (int q = 0; q < 8; ++q) v[q] = tl[(ks * 8 + q) * 65 + n];
    int nn = n0 + n;
    if (permute) nn = (nn < DFF) ? ((nn >> 6) * 128 + (nn & 63)) : ((((nn - DFF) >> 6) * 128) + 64 + ((nn - DFF) & 63));
    uint4 pk = make_uint4(pack2(v[0], v[1]), pack2(v[2], v[3]), pack2(v[4], v[5]), pack2(v[6], v[7]));
    *(uint4*)(dst + (size_t)nn * ldk + k0 + ks * 8) = pk;
  }
  __syncthreads();
}
constexpr int NCONV_MIX = 1856 + 3 * 128 + 256;
constexpr int NCONV_FFN = 1408 + 704;
DI void conv_wmix_item(const Params& p, int l, int it, char* smem) {
  float* tl = (float*)smem; unsigned char* ws = p.ws;
  if (it < 1856) conv_wtile(p.in[9] + (size_t)l * 1024 * INW, 1024, INW, (u16*)(ws + OFF_WIN), LDW1, p.in[8] + l * 1024, 0, it, tl);
  else if (it < 1856 + 384) { const int b = (it - 1856) >> 7, t = (it - 1856) & 127;
    conv_wtile(p.in[14 + b] + (size_t)l * 512 * 1024, 512, 1024, (u16*)(ws + OFF_WA + b * W_BR_B), LDW5, nullptr, 0, t, tl); }
  else conv_wtile(p.in[17] + (size_t)l * 1024 * 1024, 1024, 1024, (u16*)(ws + OFF_WOUT), LDW1, nullptr, 0, it - 2240, tl);
}
DI void conv_wffn_item(const Params& p, int l, int it, char* smem) {
  float* tl = (float*)smem; unsigned char* ws = p.ws;
  if (it < 1408) conv_wtile(p.in[19] + (size_t)l * 1024 * DFF2, 1024, DFF2, (u16*)(ws + OFF_WUP), LDW1, p.in[18] + l * 1024, 1, it, tl);
  else conv_wtile(p.in[22] + (size_t)l * DFF * 1024, DFF, 1024, (u16*)(ws + OFF_WDOWN), LDACT, nullptr, 0, it - 1408, tl);
}

DI void phase0(const Params& p, char* smem) {
  const int tid = tidx(), lane = tid & 63, wid = tid >> 6;
  float* x = p.out; u16* xb = (u16*)(p.ws + OFF_XB);
  float* rowsq1 = (float*)(p.ws + OFF_ROWSQ1); float* rowsq2 = (float*)(p.ws + OFF_ROWSQ2);
  for (int it = blockIdx.x; it < T / 4; it += gridDim.x) {
    const int row = it * 4 + wid;
    const float* src = row < TP ? p.in[0] + (size_t)row * 1024 : p.in[1] + (size_t)(row - TP) * 1024;
    float ss = 0.f;
#pragma unroll
    for (int i = 0; i < 4; ++i) {
      const int c = (i * 64 + lane) * 4;
      const float4 v = *(const float4*)(src + c);
      *(float4*)(x + (size_t)row * 1024 + c) = v;
      ss += v.x * v.x + v.y * v.y + v.z * v.z + v.w * v.w;
      *(uint2*)(xb + (size_t)row * LDX + c) = make_uint2(pack2(v.x, v.y), pack2(v.z, v.w));
    }
    ss = wave_sum(ss);
    if (lane == 0) { rowsq1[row] = ss; rowsq2[row] = 0.f; }
  }
  for (int it = blockIdx.x; it < NCONV_MIX; it += gridDim.x) conv_wmix_item(p, 0, it, smem);
  const size_t gsz = (size_t)gridDim.x * NT, g0 = (size_t)blockIdx.x * NT + tid;
  for (size_t e = g0; e < (size_t)2 * 8 * 64 * 128; e += gsz) {
    const size_t lb = e / (64 * 128), r = e % (64 * 128);
    p.out[O_AKS + lb * 128 * 128 + r] = p.in[2][lb * 128 * 128 + 64 * 128 + r];
    p.out[O_AVS + lb * 128 * 128 + r] = p.in[3][lb * 128 * 128 + 64 * 128 + r];
  }
  for (size_t e = g0; e < (size_t)2 * 8 * 448 * 512 / 4; e += gsz) {
    const size_t e4 = e * 4; const size_t lb = e4 / (448 * 512), r = e4 % (448 * 512);
    *(float4*)(p.out + O_BKS + lb * 512 * 512 + r) = *(const float4*)(p.in[4] + lb * 512 * 512 + 64 * 512 + r);
    *(float4*)(p.out + O_BVS + lb * 512 * 512 + r) = *(const float4*)(p.in[5] + lb * 512 * 512 + 64 * 512 + r);
  }
}

DI void cache_to_kv(const Params& p, int l) {
  const int tid = tidx();
  const size_t gsz = (size_t)gridDim.x * NT, g0 = (size_t)blockIdx.x * NT + tid;
  u16* Ka = (u16*)(p.ws + OFF_KA); u16* Vta = (u16*)(p.ws + OFF_VTA); u16* Kb = (u16*)(p.ws + OFF_KB); u16* Vtb = (u16*)(p.ws + OFF_VTB);
  for (size_t e = g0; e < (size_t)8 * 128 * 128 / 8; e += gsz) {
    const size_t e8 = e * 8; const int b = (int)(e8 / (128 * 128)); const int j = (int)((e8 / 128) % 128), c = (int)(e8 % 128);
    const float* s = p.in[2] + ((size_t)(l * 8 + b) * 128 + j) * 128 + c;
    const float4 v0 = *(const float4*)s, v1 = *(const float4*)(s + 4);
    *(uint4*)(Ka + (size_t)(TP + b * 192 + j) * 128 + c) = make_uint4(pack2(v0.x, v0.y), pack2(v0.z, v0.w), pack2(v1.x, v1.y), pack2(v1.z, v1.w));
  }
  for (size_t e = g0; e < (size_t)8 * 512 * 512 / 8; e += gsz) {
    const size_t e8 = e * 8; const int b = (int)(e8 / (512 * 512)); const int j = (int)((e8 / 512) % 512), c = (int)(e8 % 512);
    const float* s = p.in[4] + ((size_t)(l * 8 + b) * 512 + j) * 512 + c;
    const float4 v0 = *(const float4*)s, v1 = *(const float4*)(s + 4);
    *(uint4*)(Kb + (size_t)(TP + b * 576 + j) * 512 + c) = make_uint4(pack2(v0.x, v0.y), pack2(v0.z, v0.w), pack2(v1.x, v1.y), pack2(v1.z, v1.w));
  }
  for (size_t e = g0; e < (size_t)8 * 16 * 128; e += gsz) {
    const int c = (int)(e % 128), j8 = (int)((e / 128) % 16), b = (int)(e / (128 * 16));
    const float* s = p.in[3] + ((size_t)(l * 8 + b) * 128 + j8 * 8) * 128 + c;
    float v[8];
#pragma unroll
    for (int q = 0; q < 8; ++q) v[q] = s[(size_t)q * 128];
    *(uint4*)(Vta + (size_t)c * KA_ROWS + TP + b * 192 + j8 * 8) = make_uint4(pack2(v[0], v[1]), pack2(v[2], v[3]), pack2(v[4], v[5]), pack2(v[6], v[7]));
  }
  for (size_t e = g0; e < (size_t)8 * 64 * 512; e += gsz) {
    const int c = (int)(e % 512), j8 = (int)((e / 512) % 64), b = (int)(e / (512 * 64));
    const float* s = p.in[5] + ((size_t)(l * 8 + b) * 512 + j8 * 8) * 512 + c;
    float v[8];
#pragma unroll
    for (int q = 0; q < 8; ++q) v[q] = s[(size_t)q * 512];
    *(uint4*)(Vtb + (size_t)c * KB_ROWS + TP + b * 576 + j8 * 8) = make_uint4(pack2(v[0], v[1]), pack2(v[2], v[3]), pack2(v[4], v[5]), pack2(v[6], v[7]));
  }
}

DI void p1_tile(const Params& p, int l, int rt, int ct, char* smem) {
  const int tid = tidx();
  unsigned char* ws = p.ws;
  float* Ct = (float*)smem; float* rs = (float*)(smem + 73728);
  const float* rowsq1 = (const float*)(ws + OFF_ROWSQ1);
  const int row0 = rt * 128;
  if (tid < 128) rs[tid] = rsqrtf(rowsq1[row0 + tid] * (1.f / 1024.f) + EPS);
  f32x4 acc[4][4];
  gemm_tile<4>(acc, (const u16*)(ws + OFF_XB), LDX, row0, 0, T, (const u16*)(ws + OFF_WIN) + (size_t)ct * 128 * LDW1, LDW1, 1024, smem);
  acc_to_lds<4>(acc, Ct, rs);
  int kind, cb;
  u16* dst; int dstw;
  bool isB = false; int hplane = 0;
  if (ct < 4)       { kind = 0; cb = ct * 128;        dst = (u16*)(ws + OFF_QA); dstw = 512; }
  else if (ct == 4) { kind = 1; cb = 0;               dst = (u16*)(ws + OFF_KA); dstw = 128; }
  else if (ct == 5) { kind = 2; cb = 0;               dst = (u16*)(ws + OFF_VTA); dstw = 128; }
  else if (ct < 10) { kind = 3; cb = (ct - 6) * 128;  dst = (u16*)(ws + OFF_QB); dstw = 512; isB = true; }
  else if (ct < 14) { kind = 4; cb = (ct - 10) * 128; dst = (u16*)(ws + OFF_KB); dstw = 512; isB = true; }
  else if (ct < 18) { kind = 2; cb = (ct - 14) * 128; dst = (u16*)(ws + OFF_VTB); dstw = 512; isB = true; }
  else { kind = 3; hplane = (ct - 18) >> 2; cb = ((ct - 18) & 3) * 128; dst = (u16*)(ws + OFF_HF + (size_t)hplane * PLANE); dstw = 512; }
  const bool rope = (kind == 0 || kind == 1);
  const bool iskv = (kind == 1 || kind == 2 || kind == 4);
  const int R = isB ? 512 : 128;
  float* cache_p = nullptr; float* cache_s = nullptr;
  if (iskv) {
    const bool isv = (kind == 2);
    cache_p = p.out + (isB ? (isv ? O_BVP : O_BKP) : (isv ? O_AVP : O_AKP)) + (size_t)l * R * dstw;
    cache_s = p.out + (isB ? (isv ? O_BVS : O_BKS) : (isv ? O_AVS : O_AKS)) + (size_t)l * 8 * R * dstw;
  }
#pragma unroll 1
  for (int i = 0; i < 4; ++i) {
    const int item = tid + NT * i; const int r = item >> 3, g = item & 7;
    const int tok = row0 + r;
    float v[16];
#pragma unroll
    for (int q = 0; q < 4; ++q) { const float4 t4 = *(const float4*)(Ct + r * CTS + g * 16 + q * 4); v[q * 4] = t4.x; v[q * 4 + 1] = t4.y; v[q * 4 + 2] = t4.z; v[q * 4 + 3] = t4.w; }
    if (rope && (g & 3) == 0) {
      const float pos = (float)(tok < TP ? tok : 1024 + ((tok - TP) & 63));
#pragma unroll
      for (int d = 0; d < 8; ++d) {
        const float invf = exp2f(-(float)d * (18.931568569324174f / 8.f));
        float sn, cs; sincosf(pos * invf, &sn, &cs);
        const float x1 = v[d], x2 = v[d + 8];
        v[d] = x1 * cs - x2 * sn; v[d + 8] = x2 * cs + x1 * sn;
      }
    }
    const int col = cb + g * 16;
    if (kind != 2) {
      size_t drow;
      if (kind == 1) drow = (size_t)krowA(tok); else if (kind == 4) drow = (size_t)krowB(tok); else drow = (size_t)tok;
      u16* d = dst + drow * dstw + col;
      *(uint4*)d = make_uint4(pack2(v[0], v[1]), pack2(v[2], v[3]), pack2(v[4], v[5]), pack2(v[6], v[7]));
      *(uint4*)(d + 8) = make_uint4(pack2(v[8], v[9]), pack2(v[10], v[11]), pack2(v[12], v[13]), pack2(v[14], v[15]));
    }
    if (iskv) {
      float* cd = nullptr;
      if (tok < TP) { if (tok >= TP - R) cd = cache_p + (size_t)(tok - (TP - R)) * dstw + col; }
      else { const int s = tok - TP; cd = cache_s + ((size_t)(s >> 6) * R + (R - 64) + (s & 63)) * dstw + col; }
      if (cd) {
#pragma unroll
        for (int q = 0; q < 4; ++q) *(float4*)(cd + q * 4) = make_float4(v[q * 4], v[q * 4 + 1], v[q * 4 + 2], v[q * 4 + 3]);
      }
    }
  }
  if (kind == 2) {
    const int ROWS = isB ? KB_ROWS : KA_ROWS;
#pragma unroll 1
    for (int i = 0; i < 8; ++i) {
      const int item = tid + NT * i; const int g8 = item & 15, c = item >> 4;
      float v[8];
#pragma unroll
      for (int q = 0; q < 8; ++q) v[q] = Ct[(g8 * 8 + q) * CTS + c];
      const int tok = row0 + g8 * 8;
      const int kr = isB ? krowB(tok) : krowA(tok);
      *(uint4*)(dst + (size_t)(cb + c) * ROWS + kr) = make_uint4(pack2(v[0], v[1]), pack2(v[2], v[3]), pack2(v[4], v[5]), pack2(v[6], v[7]));
    }
  }
  __syncthreads();
}

constexpr int AT_KS = 2048;
template <bool ISB>
DI void attn_item(const Params& p, int l, int sc, int hh, char* smem) {
  constexpr int GB = ISB ? 6 : 12;
  constexpr int NG = ISB ? 6 : 1, NQH = ISB ? 1 : 4;
  constexpr int NCH = GB / 2;
  constexpr int VROW = (GB * 16 + 8) * 2;
  constexpr int AT_VS = AT_KS + GB * 16 * 144;
  const int tid = tidx(), lane = tid & 63, wid = tid >> 6, fr = lane & 15, fq = lane >> 4;
  constexpr int KW = ISB ? 512 : 128;
  constexpr int KROWS = ISB ? KB_ROWS : KA_ROWS;
  constexpr int R = ISB ? 512 : 128;
  u16* Q = (u16*)(p.ws + (ISB ? OFF_QB : OFF_QA));
  const u16* Kp = (const u16*)(p.ws + (ISB ? OFF_KB : OFF_KA));
  const u16* Vt = (const u16*)(p.ws + (ISB ? OFF_VTB : OFF_VTA));
  int tokq0, kband0, firstblk;
  if (sc < 256) { tokq0 = sc * 64; kband0 = sc * 64 - R; firstblk = kband0 < 0 ? ((-kband0) >> 4) : 0; }
  else { const int b = sc - 256; tokq0 = TP + b * 64; kband0 = TP + b * (R + 64); firstblk = 0; }
  const int hk = hh;
  const int qrow = tokq0 + wid * 16 + fr;
  const float* table = (const float*)smem;
  float tconst = 0.f;
  __syncthreads();
  if (ISB) {
    const float* gt = p.in[11] + (size_t)(l * 8 + hh) * 257;
    float* tw = (float*)smem;
    tw[tid] = gt[tid]; if (tid < 64) tw[256 + tid] = gt[256];
  }
  const int qi = wid * 16 + fr;
  const float* eb = table + (65 + qi - fq * 4);
  float m_run = -1e30f, l_run = 0.f;
  f32x4 o[4];
#pragma unroll
  for (int d = 0; d < 4; ++d) o[d] = f32x4{0.f, 0.f, 0.f, 0.f};
  bf16x8 qf[2];
  if (NQH == 1) {
#pragma unroll
    for (int kk = 0; kk < 2; ++kk) qf[kk] = *(const bf16x8*)(Q + (size_t)qrow * 512 + hh * 64 + kk * 32 + fq * 8);
  }
  uint4 kreg[NCH], vreg[NCH];
#define AT_LOAD(g_) do { const int fbl = max(firstblk - (g_) * GB, 0); const int kbl = kband0 + (g_) * (GB * 16); \
    _Pragma("unroll") for (int i = 0; i < NCH; ++i) { const int c = tid + NT * i; \
      { const int row = c >> 3, ch = c & 7; kreg[i] = make_uint4(0u, 0u, 0u, 0u); \
        if (row >= fbl * 16) kreg[i] = *(const uint4*)(Kp + (size_t)(kbl + row) * KW + hk * 64 + ch * 8); } \
      { const int row = c / (GB * 2), ch = c - row * (GB * 2); vreg[i] = make_uint4(0u, 0u, 0u, 0u); \
        if (ch * 8 >= fbl * 16) vreg[i] = *(const uint4*)(Vt + (size_t)(hk * 64 + row) * KROWS + kbl + ch * 8); } } } while (0)
#define AT_STORE() do { _Pragma("unroll") for (int i = 0; i < NCH; ++i) { const int c = tid + NT * i; \
      { const int row = c >> 3, ch = c & 7; *(uint4*)(smem + AT_KS + row * 144 + ch * 16) = kreg[i]; } \
      { const int row = c / (GB * 2), ch = c - row * (GB * 2); *(uint4*)(smem + AT_VS + row * VROW + ch * 16) = vreg[i]; } } } while (0)
  const int g0 = firstblk / GB;
  AT_LOAD(g0);
  AT_STORE();
  __syncthreads();
  if (ISB) tconst = table[256];
#pragma unroll 1
  for (int g = g0; g < NG; ++g) {
    const int fb = max(firstblk - g * GB, 0);
    if (g + 1 < NG) AT_LOAD(g + 1);
    __builtin_amdgcn_sched_barrier(0);
#pragma unroll 1
    for (int qh = 0; qh < NQH; ++qh) {
      const int h = ISB ? hh : hh * 4 + qh;
      if (NQH > 1) {
#pragma unroll
        for (int kk = 0; kk < 2; ++kk) qf[kk] = *(const bf16x8*)(Q + (size_t)qrow * 512 + h * 64 + kk * 32 + fq * 8);
        m_run = p.in[10][l * 8 + h]; l_run = 1.f;
#pragma unroll
        for (int d = 0; d < 4; ++d) o[d] = f32x4{0.f, 0.f, 0.f, 0.f};
      }
      f32x4 s[GB];
#pragma unroll
      for (int blk = 0; blk < GB; ++blk) {
        f32x4 a = {0.f, 0.f, 0.f, 0.f};
        if ((blk & 3) == 0) asm volatile("" ::: "memory");
        if (blk >= fb) {
          const char* kr = smem + AT_KS + (blk * 16 + fr) * 144 + fq * 16;
          const bf16x8 k0 = *(const bf16x8*)kr, k1 = *(const bf16x8*)(kr + 64);
          a = MFMA16(k0, qf[0], a); a = MFMA16(k1, qf[1], a);
        }
        s[blk] = a;
      }
      float mx = -1e30f;
#pragma unroll
      for (int blk = 0; blk < GB; ++blk) {
#pragma unroll
        for (int j = 0; j < 4; ++j) {
          float v = s[blk][j] * 0.125f;
          if (ISB) {
            if (g < 4) v += tconst;
            else v += eb[191 - ((g - 4) * 96 + blk * 16 + j)];
          }
          if (blk < fb) v = -1e30f;
          s[blk][j] = v; mx = fmaxf(mx, v);
        }
      }
      mx = fmaxf(mx, __shfl_xor(mx, 16, 64)); mx = fmaxf(mx, __shfl_xor(mx, 32, 64));
      const float m_new = fmaxf(m_run, mx);
      const float scale = __expf(m_run - m_new);
      m_run = m_new;
      float sum = 0.f;
#pragma unroll
      for (int blk = 0; blk < GB; ++blk)
#pragma unroll
        for (int j = 0; j < 4; ++j) { const float e = __expf(s[blk][j] - m_new); s[blk][j] = e; sum += e; }
      sum += __shfl_xor(sum, 16, 64); sum += __shfl_xor(sum, 32, 64);
      l_run = l_run * scale + sum;
#pragma unroll
      for (int d = 0; d < 4; ++d) { o[d][0] *= scale; o[d][1] *= scale; o[d][2] *= scale; o[d][3] *= scale; }
#pragma unroll
      for (int pp = 0; pp < GB / 2; ++pp) {
        if ((pp & 1) == 0) asm volatile("" ::: "memory");
        if (2 * pp >= fb) {
          uint4 pk = make_uint4(pack2(s[2 * pp][0], s[2 * pp][1]), pack2(s[2 * pp][2], s[2 * pp][3]),
                                pack2(s[2 * pp + 1][0], s[2 * pp + 1][1]), pack2(s[2 * pp + 1][2], s[2 * pp + 1][3]));
          const bf16x8 pb = __builtin_bit_cast(bf16x8, pk);
#pragma unroll
          for (int d = 0; d < 4; ++d) {
            const char* vr = smem + AT_VS + (d * 16 + fr) * VROW + (pp * 32 + fq * 4) * 2;
            const uint2 lo = *(const uint2*)vr, hi = *(const uint2*)(vr + 32);
            const bf16x8 va = __builtin_bit_cast(bf16x8, make_uint4(lo.x, lo.y, hi.x, hi.y));
            o[d] = MFMA16(va, pb, o[d]);
          }
        }
      }
      if (NQH > 1) {
        const float inv = rcpf_(l_run);
#pragma unroll
        for (int d = 0; d < 4; ++d)
          *(uint2*)(Q + (size_t)qrow * 512 + h * 64 + d * 16 + fq * 4) = make_uint2(pack2(o[d][0] * inv, o[d][1] * inv), pack2(o[d][2] * inv, o[d][3] * inv));
      }
    }
    if (g + 1 < NG) {
      __syncthreads();
      AT_STORE();
      __syncthreads();
    }
  }
#undef AT_LOAD
#undef AT_STORE
  if (NQH == 1) {
    const float inv = rcpf_(l_run);
#pragma unroll
    for (int d = 0; d < 4; ++d)
      *(uint2*)(Q + (size_t)qrow * 512 + hh * 64 + d * 16 + fq * 4) = make_uint2(pack2(o[d][0] * inv, o[d][1] * inv), pack2(o[d][2] * inv, o[d][3] * inv));
  }
}

using s16x4 = __attribute__((ext_vector_type(4))) short;
#define MFMA16K(a, b, c) __builtin_amdgcn_mfma_f32_16x16x16bf16_1k((a), (b), (c), 0, 0, 0)
DI s16x4 pack4(float a, float b, float c, float d) { return __builtin_bit_cast(s16x4, make_uint2(pack2(a, b), pack2(c, d))); }
constexpr int QDS = 132, KTS = 24;
template <bool OUT>
DI void hgrn_item(const Params& p, int l, int cidx, int h, char* smem) {
  const int tid = tidx(), lane = tid & 63, wid = tid >> 6, fr = lane & 15, fq = lane >> 4;
  const int kcol = tid & 127, half = tid >> 7;
  unsigned char* ws = p.ws;
  u16* QD = (u16*)smem;
  u16* KP = QD + 16 * QDS;
  u16* KDT = KP + 16 * QDS;
  u16* VT = KDT + 128 * KTS;
  float* dec = (float*)(VT + 128 * KTS);
  float* tot = dec + 128;
  float* ssum = tot + 256;
  const u16* Hf = (const u16*)(ws + OFF_HF); const u16* Hi = (const u16*)(ws + OFF_HI);
  u16* Hq = (u16*)(ws + OFF_HQ); const u16* Hog = (const u16*)(ws + OFF_HOG);
  const bool sample = OUT && cidx >= 128;
  const int tok_base = sample ? TP + (cidx - 128) * 64 : cidx * 128;
  const int nsb = sample ? 4 : 8;
  float lb = 0.f;
  if (l == 1) lb = sigmoidf_(p.in[12][512 + h * 128 + kcol] - p.in[12][h * 128 + kcol]);
  f32x4 S[8][2];
  if (OUT) {
    const float* s0 = sample ? p.in[6] + ((size_t)(l * 8 + (cidx - 128)) * 4 + h) * 16384
                             : (const float*)(ws + OFF_ST) + ((size_t)cidx * 4 + h) * 16384;
    const float* ps = s0 + (size_t)(fq * 4) * 128 + wid * 32 + fr;
#pragma unroll
    for (int kb = 0; kb < 8; ++kb) {
      asm volatile("" : "+v"(ps));
#pragma unroll
      for (int vb = 0; vb < 2; ++vb)
#pragma unroll
        for (int i = 0; i < 4; ++i) S[kb][vb][i] = ps[i * 128 + vb * 16];
      ps += 16 * 128;
    }
  } else {
#pragma unroll
    for (int kb = 0; kb < 8; ++kb)
#pragma unroll
      for (int vb = 0; vb < 2; ++vb) S[kb][vb] = f32x4{0.f, 0.f, 0.f, 0.f};
  }
  float lastsum = 0.f;
  u16 nf[8], nq[8], ni[8];
  {
    const size_t off0 = (size_t)(tok_base + half * 8) * 512 + h * 128 + kcol;
#pragma unroll
    for (int i = 0; i < 8; ++i) { nf[i] = Hf[off0 + (size_t)i * 512]; ni[i] = Hi[off0 + (size_t)i * 512]; nq[i] = OUT ? Hq[off0 + (size_t)i * 512] : (u16)0; }
  }
#pragma unroll 1
  for (int sb = 0; sb < nsb; ++sb) {
    const int tok0 = tok_base + sb * 16;
    __syncthreads();
    float lf[8], kk8[8], q8[8], vv[8];
    float zf[8], qf_[8];
#pragma unroll
    for (int i = 0; i < 8; ++i) { zf[i] = bf2f(nf[i]); qf_[i] = bf2f(nq[i]); vv[i] = bf2f(ni[i]); }
    if (sb + 1 < nsb) {
      const size_t off0 = (size_t)(tok0 + 16 + half * 8) * 512 + h * 128 + kcol;
#pragma unroll
      for (int i = 0; i < 8; ++i) { nf[i] = Hf[off0 + (size_t)i * 512]; ni[i] = Hi[off0 + (size_t)i * 512]; if (OUT) nq[i] = Hq[off0 + (size_t)i * 512]; }
    }
    __builtin_amdgcn_sched_barrier(0);
    {
      float run = 0.f;
#pragma unroll
      for (int i = 0; i < 8; ++i) {
        const float z = zf[i];
        const float e = __expf(-fabsf(z));
        const float sp = rcpf_(1.f + e);
        const float sig = z >= 0.f ? sp : e * sp;
        const float nsig = z >= 0.f ? e * sp : sp;
        float lfi;
        if (lb > 0.f) lfi = __logf(lb + (1.f - lb) * sig);
        else lfi = fminf(z, 0.f) - __logf(1.f + e);
        run += lfi; lf[i] = run;
        kk8[i] = (1.f - lb) * nsig;
        if (OUT) { const float qp = qf_[i]; q8[i] = qp * sigmoidf_(qp); } else q8[i] = 0.f;
      }
      tot[half * 128 + kcol] = run;
    }
    __syncthreads();
    {
      const float t0 = tot[kcol], t1 = tot[128 + kcol];
      const float last = t0 + t1, base = half ? t0 : 0.f;
      float kd[8];
#pragma unroll
      for (int i = 0; i < 8; ++i) {
        const float cum = base + lf[i];
        kd[i] = kk8[i] * __expf(last - cum);
        if (OUT) {
          QD[(half * 8 + i) * QDS + kcol] = f2bf(q8[i] * __expf(cum));
          KP[(half * 8 + i) * QDS + kcol] = f2bf(kk8[i] * __expf(fminf(-cum, 80.f)));
        }
      }
      *(uint4*)(KDT + kcol * KTS + half * 8) = make_uint4(pack2(kd[0], kd[1]), pack2(kd[2], kd[3]), pack2(kd[4], kd[5]), pack2(kd[6], kd[7]));
      *(uint4*)(VT + kcol * KTS + half * 8) = make_uint4(pack2(vv[0], vv[1]), pack2(vv[2], vv[3]), pack2(vv[4], vv[5]), pack2(vv[6], vv[7]));
      if (half == 0) dec[kcol] = __expf(last);
      lastsum += last;
    }
    __syncthreads();
    s16x4 vtf[2];
#pragma unroll
    for (int vb = 0; vb < 2; ++vb) vtf[vb] = *(const s16x4*)(VT + (wid * 32 + vb * 16 + fr) * KTS + fq * 4);
    if (OUT) {
      uint2 ogp[2]; float4 cn4[2];
#pragma unroll
      for (int vb = 0; vb < 2; ++vb) {
        const int vcol = h * 128 + wid * 32 + vb * 16 + fq * 4;
        ogp[vb] = *(const uint2*)(Hog + (size_t)(tok0 + fr) * 512 + vcol);
        cn4[vb] = *(const float4*)(p.in[13] + l * 512 + vcol);
      }
      __builtin_amdgcn_sched_barrier(0);
      s16x4 qdf[8];
#pragma unroll
      for (int kb = 0; kb < 8; ++kb) qdf[kb] = *(const s16x4*)(QD + fr * QDS + kb * 16 + fq * 4);
      f32x4 at = {0.f, 0.f, 0.f, 0.f};
#pragma unroll
      for (int kb = 0; kb < 8; ++kb) { const s16x4 kpf = *(const s16x4*)(KP + fr * QDS + kb * 16 + fq * 4); at = MFMA16K(kpf, qdf[kb], at); }
#pragma unroll
      for (int i = 0; i < 4; ++i) if (fq * 4 + i > fr) at[i] = 0.f;
      const s16x4 atb = pack4(at[0], at[1], at[2], at[3]);
      f32x4 ot[2];
#pragma unroll
      for (int vb = 0; vb < 2; ++vb) {
        f32x4 o = {0.f, 0.f, 0.f, 0.f};
#pragma unroll
        for (int kb = 0; kb < 8; ++kb) o = MFMA16K(pack4(S[kb][vb][0], S[kb][vb][1], S[kb][vb][2], S[kb][vb][3]), qdf[kb], o);
        o = MFMA16K(vtf[vb], atb, o);
        ot[vb] = o;
      }
      float ss = 0.f;
#pragma unroll
      for (int vb = 0; vb < 2; ++vb)
#pragma unroll
        for (int i = 0; i < 4; ++i) ss += ot[vb][i] * ot[vb][i];
      ss += __shfl_xor(ss, 16, 64); ss += __shfl_xor(ss, 32, 64);
      if (fq == 0) ssum[wid * 16 + fr] = ss;
      __syncthreads();
      const float rn = rsqrtf((ssum[fr] + ssum[16 + fr] + ssum[32 + fr] + ssum[48 + fr]) * (1.f / 128.f) + EPS);
#pragma unroll
      for (int vb = 0; vb < 2; ++vb) {
        const int vcol = h * 128 + wid * 32 + vb * 16 + fq * 4;
        const size_t off = (size_t)(tok0 + fr) * 512 + vcol;
        const float4 cn = cn4[vb];
        const float g0 = lo_f(ogp[vb].x), g1 = hi_f(ogp[vb].x), g2 = lo_f(ogp[vb].y), g3 = hi_f(ogp[vb].y);
        *(uint2*)(Hq + off) = make_uint2(pack2(ot[vb][0] * rn * cn.x * (g0 * sigmoidf_(g0)), ot[vb][1] * rn * cn.y * (g1 * sigmoidf_(g1))),
                                         pack2(ot[vb][2] * rn * cn.z * (g2 * sigmoidf_(g2)), ot[vb][3] * rn * cn.w * (g3 * sigmoidf_(g3))));
      }
    }
#pragma unroll
    for (int kb = 0; kb < 8; ++kb) {
      const float4 d4 = *(const float4*)(dec + kb * 16 + fq * 4);
      const s16x4 kdf = *(const s16x4*)(KDT + (kb * 16 + fr) * KTS + fq * 4);
#pragma unroll
      for (int vb = 0; vb < 2; ++vb) {
        f32x4 t = S[kb][vb];
        t[0] *= d4.x; t[1] *= d4.y; t[2] *= d4.z; t[3] *= d4.w;
        S[kb][vb] = MFMA16K(kdf, vtf[vb], t);
      }
    }
  }
  if (!OUT || sample) {
    float* D = OUT ? p.out + O_CS + ((size_t)(l * 8 + (cidx - 128)) * 4 + h) * 16384
                   : (float*)(ws + OFF_ST) + ((size_t)cidx * 4 + h) * 16384;
    float* pd = D + (size_t)(fq * 4) * 128 + wid * 32 + fr;
#pragma unroll
    for (int kb = 0; kb < 8; ++kb) {
      asm volatile("" : "+v"(pd));
#pragma unroll
      for (int vb = 0; vb < 2; ++vb)
#pragma unroll
        for (int i = 0; i < 4; ++i) pd[i * 128 + vb * 16] = S[kb][vb][i];
      pd += 16 * 128;
    }
    if (!OUT && half == 0) ((float*)(ws + OFF_DECAY))[((size_t)cidx * 4 + h) * 128 + kcol] = __expf(lastsum);
  }
  __syncthreads();
}

DI void hgrn_scan(const Params& p, int l) {
  float* ST = (float*)(p.ws + OFF_ST); const float* DEC = (const float*)(p.ws + OFF_DECAY);
  for (int e = blockIdx.x * NT + tidx(); e < 65536; e += gridDim.x * NT) {
    const int h = e >> 14, k = (e >> 7) & 127;
    float S = 0.f;
    float* ptr = ST + (size_t)h * 16384 + (e & 16383);
    const float* dp = DEC + h * 128 + k;
#pragma unroll 1
    for (int c0 = 0; c0 < 128; c0 += 8) {
      float d[8], dc[8];
#pragma unroll
      for (int i = 0; i < 8; ++i) { d[i] = ptr[(size_t)(c0 + i) * 65536]; dc[i] = dp[(c0 + i) * 512]; }
#pragma unroll
      for (int i = 0; i < 8; ++i) { ptr[(size_t)(c0 + i) * 65536] = S; S = dc[i] * S + d[i]; }
    }
    p.out[O_CP + (size_t)l * 65536 + e] = S;
  }
}

template <int NB>
DI void p5_tile(const Params& p, int l, int rt, int c0, char* smem) {
  const int tid = tidx(), lane = tid & 63, wid = tid >> 6, wr = wid >> 1, fq = lane >> 4;
  unsigned char* ws = p.ws;
  float* Ct = (float*)smem; float* rs = (float*)(smem + 73728);
  const float* rowsq1 = (const float*)(ws + OFF_ROWSQ1);
  const int row0 = rt * 128;
  __syncthreads();
  if (tid < 128) rs[tid] = rsqrtf(rowsq1[row0 + tid] * (1.f / 1024.f) + EPS);
  uint2 mixp[4][NB];
#pragma unroll
  for (int m = 0; m < 4; ++m)
#pragma unroll
    for (int n = 0; n < NB; ++n) mixp[m][n] = make_uint2(0u, 0u);
#pragma unroll 1
  for (int br = 0; br < 3; ++br) {
    f32x4 acc[4][NB];
    gemm_tile<NB>(acc, (const u16*)(ws + OFF_XB), LDX, row0, 0, T, (const u16*)(ws + OFF_WIN) + (size_t)(NIN1 + br * 1024 + c0) * LDW1, LDW1, 1024, smem);
    unsigned sg[4][NB];
#pragma unroll
    for (int m = 0; m < 4; ++m) {
      const float4 r4 = *(const float4*)(rs + wr * 64 + m * 16 + fq * 4);
#pragma unroll
      for (int n = 0; n < NB; ++n) {
        const unsigned q0 = (unsigned)(sigmoidf_(acc[m][n][0] * r4.x) * 255.f + 0.5f), q1 = (unsigned)(sigmoidf_(acc[m][n][1] * r4.y) * 255.f + 0.5f);
        const unsigned q2 = (unsigned)(sigmoidf_(acc[m][n][2] * r4.z) * 255.f + 0.5f), q3 = (unsigned)(sigmoidf_(acc[m][n][3] * r4.w) * 255.f + 0.5f);
        unsigned w_ = q0 | (q1 << 8) | (q2 << 16) | (q3 << 24);
        asm volatile("" : "+v"(w_));
        sg[m][n] = w_;
      }
    }
    const u16* Ob = (const u16*)(ws + (br == 0 ? OFF_QA : (br == 1 ? OFF_QB : OFF_HQ)));
    gemm_tile<NB>(acc, Ob, 512, row0, 0, T, (const u16*)(ws + OFF_WA + br * W_BR_B) + (size_t)c0 * LDW5, LDW5, 512, smem);
#pragma unroll
    for (int m = 0; m < 4; ++m)
#pragma unroll
      for (int n = 0; n < NB; ++n) {
        const uint2 prev = mixp[m][n];
        const unsigned w = sg[m][n];
        const float k255 = 1.f / 255.f;
        const float m0 = lo_f(prev.x) + (float)(w & 255u) * k255 * acc[m][n][0], m1 = hi_f(prev.x) + (float)((w >> 8) & 255u) * k255 * acc[m][n][1];
        const float m2 = lo_f(prev.y) + (float)((w >> 16) & 255u) * k255 * acc[m][n][2], m3 = hi_f(prev.y) + (float)(w >> 24) * k255 * acc[m][n][3];
        unsigned px = pack2(m0, m1), py = pack2(m2, m3);
        asm volatile("" : "+v"(px), "+v"(py));
        mixp[m][n] = make_uint2(px, py);
      }
  }
  {
    f32x4 mix[4][NB];
#pragma unroll
    for (int m = 0; m < 4; ++m)
#pragma unroll
      for (int n = 0; n < NB; ++n) { const uint2 q = mixp[m][n]; mix[m][n] = f32x4{lo_f(q.x), hi_f(q.x), lo_f(q.y), hi_f(q.y)}; }
    acc_to_lds<NB>(mix, Ct, nullptr);
  }
  u16* mixb = (u16*)(ws + OFF_MIX);
#pragma unroll 1
  for (int i = 0; i < NB; ++i) {
    const int item = tid + NT * i; const int r = item / (NB * 2), g = item % (NB * 2);
    float v[16];
#pragma unroll
    for (int q = 0; q < 4; ++q) { const float4 t4 = *(const float4*)(Ct + r * CTS + g * 16 + q * 4); v[q * 4] = t4.x; v[q * 4 + 1] = t4.y; v[q * 4 + 2] = t4.z; v[q * 4 + 3] = t4.w; }
    u16* d = mixb + (size_t)(row0 + r) * LDX + c0 + g * 16;
    *(uint4*)d = make_uint4(pack2(v[0], v[1]), pack2(v[2], v[3]), pack2(v[4], v[5]), pack2(v[6], v[7]));
    *(uint4*)(d + 8) = make_uint4(pack2(v[8], v[9]), pack2(v[10], v[11]), pack2(v[12], v[13]), pack2(v[14], v[15]));
  }
  __syncthreads();
}

template <int NB>
DI void resid_tile(const Params& p, const u16* A, int lda, const u16* W, int ldw, int K, float* rowsq, int rt, int c0, char* smem) {
  const int tid = tidx();
  float* Ct = (float*)smem;
  const int row0 = rt * 128;
  constexpr int NGRP = NB * 2;
  f32x4 acc[4][NB];
  gemm_tile<NB>(acc, A, lda, row0, 0, T, W + (size_t)c0 * ldw, ldw, K, smem);
  acc_to_lds<NB>(acc, Ct, nullptr);
  float* x = p.out; u16* xb = (u16*)(p.ws + OFF_XB);
#pragma unroll
  for (int i = 0; i < NB; ++i) {
    const int item = tid + NT * i; const int r = item / NGRP, g = item % NGRP;
    float* xp = x + (size_t)(row0 + r) * 1024 + c0 + g * 16;
    float v[16]; float ss = 0.f;
#pragma unroll
    for (int q = 0; q < 4; ++q) {
      const float4 t4 = *(const float4*)(Ct + r * CTS + g * 16 + q * 4); float4 x4 = *(const float4*)(xp + q * 4);
      x4.x += t4.x; x4.y += t4.y; x4.z += t4.z; x4.w += t4.w;
      *(float4*)(xp + q * 4) = x4;
      v[q * 4] = x4.x; v[q * 4 + 1] = x4.y; v[q * 4 + 2] = x4.z; v[q * 4 + 3] = x4.w;
      ss += x4.x * x4.x + x4.y * x4.y + x4.z * x4.z + x4.w * x4.w;
    }
    u16* d = xb + (size_t)(row0 + r) * LDX + c0 + g * 16;
    *(uint4*)d = make_uint4(pack2(v[0], v[1]), pack2(v[2], v[3]), pack2(v[4], v[5]), pack2(v[6], v[7]));
    *(uint4*)(d + 8) = make_uint4(pack2(v[8], v[9]), pack2(v[10], v[11]), pack2(v[12], v[13]), pack2(v[14], v[15]));
    ss += __shfl_xor(ss, 1, 64);
    if (NGRP > 2) { ss += __shfl_xor(ss, 2, 64); ss += __shfl_xor(ss, 4, 64); }
    if (g == 0) atomicAdd(rowsq + row0 + r, ss);
  }
  __syncthreads();
}

DI float gelu_tanh(float g) { const float u = 0.7978845608028654f * (g + 0.044715f * g * g * g); return g * rcpf_(1.f + __expf(-2.f * u)); }
DI void p7_tile(const Params& p, int l, int rt, int ct, char* smem) {
  const int tid = tidx();
  unsigned char* ws = p.ws;
  float* Ct = (float*)smem; float* rs = (float*)(smem + 73728);
  const float* rowsq2 = (const float*)(ws + OFF_ROWSQ2);
  const bool sample = rt >= 131;
  const int base = sample ? TP + (rt - 131) * 128 : rt * 126 - 2;
  const int lo = sample ? TP : 0, hi = sample ? T : TP;
  __syncthreads();
  if (tid < 128) { const int g = base + tid; rs[tid] = (g >= lo && g < hi) ? rsqrtf(rowsq2[g] * (1.f / 1024.f) + EPS) : 0.f; }
  const float* wconv = p.in[20] + (size_t)l * 3 * DFF2; const float* bconv = p.in[21] + (size_t)l * DFF2;
  const float* cstate = p.in[7] + (size_t)l * 8 * 2 * DFF2;
  u16* act = (u16*)(ws + OFF_ACT);
  const int jp = tid & 31;
  float cw[4][4];
#pragma unroll
  for (int q = 0; q < 2; ++q)
#pragma unroll
    for (int ug = 0; ug < 2; ++ug) {
      const int oc = ug * DFF + ct * 64 + jp * 2 + q;
      cw[q * 2 + ug][0] = bconv[oc]; cw[q * 2 + ug][1] = wconv[oc]; cw[q * 2 + ug][2] = wconv[DFF2 + oc]; cw[q * 2 + ug][3] = wconv[2 * DFF2 + oc];
    }
  f32x4 acc[4][4];
  gemm_tile<4>(acc, (const u16*)(ws + OFF_XB), LDX, base, lo, hi, (const u16*)(ws + OFF_WUP) + (size_t)ct * 128 * LDW1, LDW1, 1024, smem);
  acc_to_lds<4>(acc, Ct, rs);
  const int rbase = (tid >> 5) * 16;
  float w1[4], w0[4];
#pragma unroll
  for (int c = 0; c < 4; ++c) {
    const int lc = jp * 2 + (c >> 1) + (c & 1) * 64;
    w1[c] = rbase >= 1 ? Ct[(rbase - 1) * CTS + lc] : 0.f;
    w0[c] = rbase >= 2 ? Ct[(rbase - 2) * CTS + lc] : 0.f;
  }
#pragma unroll 4
  for (int i = 0; i < 16; ++i) {
    const int r = rbase + i;
    const int tok = base + r;
    bool valid; int bi = 0, ti = 2;
    if (sample) { valid = true; bi = (tok - TP) >> 6; ti = (tok - TP) & 63; }
    else valid = (r >= 2) && (tok < TP);
    float cv[4], u2v[4];
#pragma unroll
    for (int c = 0; c < 4; ++c) {
      const int q = c >> 1, ug = c & 1;
      const int jc = jp * 2 + q;
      const int lc = jc + ug * 64;
      const int oc = ug * DFF + ct * 64 + jc;
      const float u2 = Ct[r * CTS + lc];
      float u1 = w1[c], u0 = w0[c];
      if (sample && ti < 2) { u1 = (ti >= 1) ? u1 : cstate[((size_t)bi * 2 + 1) * DFF2 + oc]; u0 = cstate[((size_t)bi * 2 + ti) * DFF2 + oc]; }
      cv[c] = cw[c][0] + cw[c][1] * u0 + cw[c][2] * u1 + cw[c][3] * u2;
      u2v[c] = u2; w0[c] = w1[c]; w1[c] = u2;
      if (valid) {
        if (!sample) { if (tok >= TP - 2) p.out[O_CVP + ((size_t)l * 2 + (tok - (TP - 2))) * DFF2 + oc] = u2; }
        else if (ti >= 62) p.out[O_CVS + (((size_t)l * 8 + bi) * 2 + (ti - 62)) * DFF2 + oc] = u2;
      }
    }
    if (valid) *(unsigned*)(act + (size_t)tok * LDACT + ct * 64 + jp * 2) = pack2(cv[0] * gelu_tanh(cv[1]), cv[2] * gelu_tanh(cv[3]));
  }
  __syncthreads();
}

DI void final_norm(const Params& p) {
  const int lane = tidx() & 63, wid = tidx() >> 6;
  const float* rowsq1 = (const float*)(p.ws + OFF_ROWSQ1);
  for (int it = blockIdx.x; it < T / 4; it += gridDim.x) {
    const int row = it * 4 + wid;
    const float rstd = rsqrtf(rowsq1[row] * (1.f / 1024.f) + EPS);
#pragma unroll
    for (int i = 0; i < 4; ++i) {
      const int c = (i * 64 + lane) * 4;
      float4 v = *(float4*)(p.out + (size_t)row * 1024 + c);
      const float4 g = *(const float4*)(p.in[23] + c);
      v.x *= rstd * g.x; v.y *= rstd * g.y; v.z *= rstd * g.z; v.w *= rstd * g.w;
      *(float4*)(p.out + (size_t)row * 1024 + c) = v;
    }
  }
}

DI int vblock(int b, int G) { const int nper = G >> 3; return (G & 7) ? b : ((b & 7) * nper + (b >> 3)); }
DI void tile_map(int j, int nrt, int nct, int& rt, int& ct) {
  constexpr int GR = TILE_GR;
  const int gw = GR * nct; const int g = j / gw, w = j - g * gw; const int gsz = min(GR, nrt - GR * g);
  ct = w / gsz; rt = GR * g + (w - ct * gsz);
}

__global__ void __launch_bounds__(NT, 2) fwd_megakernel(Params p) {
  extern __shared__ __attribute__((aligned(16))) char smem[];
  cg::grid_group grid = cg::this_grid();
#if USE_CG_SYNC
#define GSYNC() grid.sync()
#else
  __shared__ uint4 xb_words;
  if (threadIdx.x == 0) xb_words = make_uint4(0u, 0u, 0u, 0u);
  __syncthreads();
  XcdBarrier xb = xcd_barrier_post((unsigned*)(p.ws + OFF_BAR), (volatile LAS unsigned*)&xb_words);
  if (gridDim.y == 12345u) grid.sync();
#define GSYNC() xcd_barrier(xb)
#endif
  const int G = gridDim.x, bid = blockIdx.x;
  int vb = vblock(bid, G);
  int rt_, ct_;
  unsigned long long tacc = 0, tmark = 0;
#define TBEG(id) do { if (TPROBE == (id)) tmark = __builtin_amdgcn_s_memrealtime(); } while (0)
#define TEND(id) do { if (TPROBE == (id)) tacc += __builtin_amdgcn_s_memrealtime() - tmark; } while (0)
  unsigned char* ws = p.ws;
  TBEG(9); if (PHM & 1) phase0(p, smem);
  GSYNC(); TEND(9);
#if !USE_CG_SYNC
  {
    unsigned* bar = (unsigned*)(p.ws + OFF_BAR);
    bool even = (G & 7) == 0;
    for (int j = 0; j < 16; ++j) { const unsigned c = xb_ld(&bar[XB_XCNT(j)]); even = even && (c == (j < 8 ? (unsigned)(G >> 3) : 0u)); }
    if (even) vb = (int)xb.x * (G >> 3) + (int)xb_words.z;
  }
#endif
  for (int l = 0; l < 2; ++l) {
    TBEG(1);
    if (PHM & 2) cache_to_kv(p, l);
    for (int rep = 0; rep < ((DBL & 1) ? 2 : 1); ++rep)
    if (PHM & 2) for (int it = vb; it < 132 * 34; it += G) { tile_map(it, 132, 34, rt_, ct_); p1_tile(p, l, rt_, ct_, smem); }
    { float* rq2 = (float*)(ws + OFF_ROWSQ2); for (int i = bid * NT + threadIdx.x; i < T; i += G * NT) rq2[i] = 0.f; }
    GSYNC(); TEND(1);
    TBEG(2);
    for (int it0 = bid; it0 < 32 + 264 * 8 + 512 + 264 * 2; it0 += G) {
      if (it0 < 32) { hgrn_item<true>(p, l, 128 + (it0 >> 2), it0 & 3, smem); continue; }
      const int it = it0 - 32;
      if (it < 2112) { if (PHM & 4) attn_item<true>(p, l, it >> 3, it & 7, smem); }
      else if (it < 2624) { const int j = it - 2112; if (PHM & 8) hgrn_item<false>(p, l, j >> 2, j & 3, smem); }
      else { const int j = it - 2624; if (PHM & 16) attn_item<false>(p, l, j >> 1, j & 1, smem); }
    }
    GSYNC(); TEND(2);
    TBEG(3);
    if (PHM & 32) hgrn_scan(p, l);
    GSYNC(); TEND(3);
    TBEG(4);
    if (PHM & 64) for (int it = bid; it < 128 * 4; it += G) hgrn_item<true>(p, l, it >> 2, it & 3, smem);
    GSYNC(); TEND(4);
    TBEG(5);
    for (int rep = 0; rep < ((DBL & 2) ? 2 : 1); ++rep)
    if (PHM & 256) for (int it = vb; it < 1024 + 64; it += G) {
      if (it < 1024) { tile_map(it, 128, 8, rt_, ct_); p5_tile<4>(p, l, rt_, ct_ * 128, smem); }
      else { const int j = it - 1024; p5_tile<2>(p, l, 128 + (j >> 4), (j & 15) * 64, smem); }
    }
    if (PHM & 128) {
      if (G > 128) { if (vb >= 64) for (int it = vb - 64; it < NCONV_FFN; it += G - 64) conv_wffn_item(p, l, it, smem); }
      else for (int it = vb; it < NCONV_FFN; it += G) conv_wffn_item(p, l, it, smem);
    }
    GSYNC(); TEND(5);
    TBEG(6);
    { float* rq1 = (float*)(ws + OFF_ROWSQ1); for (int i = bid * NT + threadIdx.x; i < T; i += G * NT) rq1[i] = 0.f; }
    if (PHM & 512) for (int it = vb; it < 1024 + 128; it += G) {
      if (it < 1024) { tile_map(it, 128, 8, rt_, ct_);
        resid_tile<4>(p, (const u16*)(ws + OFF_MIX), LDX, (const u16*)(ws + OFF_WOUT), LDW1, 1024, (float*)(ws + OFF_ROWSQ2), rt_, ct_ * 128, smem); }
      else { const int j = it - 1024;
        resid_tile<1>(p, (const u16*)(ws + OFF_MIX), LDX, (const u16*)(ws + OFF_WOUT), LDW1, 1024, (float*)(ws + OFF_ROWSQ2), 128 + (j >> 5), (j & 31) * 32, smem); }
    }
    GSYNC(); TEND(6);
    TBEG(7);
    for (int rep = 0; rep < ((DBL & 4) ? 2 : 1); ++rep)
    if (PHM & 1024) for (int it = vb; it < 135 * 44; it += G) { tile_map(it, 135, 44, rt_, ct_); p7_tile(p, l, rt_, ct_, smem); }
    GSYNC(); TEND(7);
    TBEG(8);
    if (PHM & 2048) for (int it = vb; it < 1024 + 128; it += G) {
      if (it < 1024) { tile_map(it, 128, 8, rt_, ct_);
        resid_tile<4>(p, (const u16*)(ws + OFF_ACT), LDACT, (const u16*)(ws + OFF_WDOWN), LDACT, DFF, (float*)(ws + OFF_ROWSQ1), rt_, ct_ * 128, smem); }
      else { const int j = it - 1024;
        resid_tile<1>(p, (const u16*)(ws + OFF_ACT), LDACT, (const u16*)(ws + OFF_WDOWN), LDACT, DFF, (float*)(ws + OFF_ROWSQ1), 128 + (j >> 5), (j & 31) * 32, smem); }
    }
    if (l == 0) {
      if (G > 256) { if (vb >= 128) for (int it = vb - 128; it < NCONV_MIX; it += G - 128) conv_wmix_item(p, 1, it, smem); }
      else for (int it = vb; it < NCONV_MIX; it += G) conv_wmix_item(p, 1, it, smem);
    }
    GSYNC(); TEND(8);
  }
  final_norm(p);
  if (TPROBE != 0 && bid == 0) { const unsigned long long t0 = __builtin_amdgcn_s_memrealtime(); while (__builtin_amdgcn_s_memrealtime() - t0 < 4 * tacc) __builtin_amdgcn_s_sleep(8); }
}

extern "C" void kernel_launch(void* const* d_in, const int* in_sizes, int n_in, void* d_out, int out_size,
                              void* d_ws, size_t ws_size, hipStream_t stream) {
  static int grid_blocks = 0;
  if (!grid_blocks) {
    int dev = 0, cus = 0, per_cu = 0;
    hipGetDevice(&dev);
    hipDeviceGetAttribute(&cus, hipDeviceAttributeMultiprocessorCount, dev);
    hipFuncSetAttribute((const void*)fwd_megakernel, hipFuncAttributeMaxDynamicSharedMemorySize, LDS_BYTES);
    hipOccupancyMaxActiveBlocksPerMultiprocessor(&per_cu, (const void*)fwd_megakernel, NT, LDS_BYTES);
    if (per_cu < 1) per_cu = 1;
    if (per_cu > 2) per_cu = 2;
    grid_blocks = cus * per_cu;
    if (grid_blocks > 512) grid_blocks = 512;
    if (ws_size < WS_END2 || (size_t)out_size < O_END || n_in < 24)
      fprintf(stderr, "kernel_launch: unexpected sizes ws=%zu need=%zu out=%d need=%zu n_in=%d\n", ws_size, (size_t)WS_END, out_size, (size_t)O_END, n_in);
  }
  Params p{};
  for (int i = 0; i < 24; ++i) p.in[i] = (const float*)d_in[i];
  p.out = (float*)d_out; p.ws = (unsigned char*)d_ws;
  hipMemsetAsync((char*)d_ws + OFF_BAR, 0, 16384, stream);
  void* args[] = {&p};
  hipError_t e = hipLaunchCooperativeKernel((const void*)fwd_megakernel, dim3(grid_blocks), dim3(NT), args, LDS_BYTES, stream);
  if (e != hipSuccess) fprintf(stderr, "cooperative launch failed: %s (grid %d)\n", hipGetErrorString(e), grid_blocks);
}
```
